# Optimizing an MI355X kernel written in HIP

```python
import math
import jax, jax.numpy as jnp
from jax import lax
import numpy as np

D_MODEL = 2048
BATCH = 4
SEQ = 4096
DEPTH = 2

D_MIX = D_MODEL
D_HYENA = D_MIX // 4
D_SCONV = D_MIX // 4
N_HEADS = 16
N_KV_HEADS = 4
GROUP = N_HEADS // N_KV_HEADS
HEAD_DIM = 64
D_ATTN = N_HEADS * HEAD_DIM
D_KV = N_KV_HEADS * HEAD_DIM
SPLIT_SC = 3 * D_HYENA
SPLIT_Q = SPLIT_SC + 3 * D_SCONV
SPLIT_K = SPLIT_Q + D_ATTN
SPLIT_V = SPLIT_K + D_KV
D_IN_PROJ = SPLIT_V + D_KV
D_FF = 5632
WINDOW = 128
BLOCK = 128
CONV_WIDTH = 3
FILTER_BANDS = 16
FILTER_EMB_DIM = 1 + 2 * FILTER_BANDS
FILTER_HIDDEN = 64
HYENA_FAST_DECAY = 0.3
HYENA_SLOW_DECAY = 1.5
HYENA_DECAY_TARGET = 1e-2
HYENA_MIN_DECAY = math.log(HYENA_DECAY_TARGET) / HYENA_SLOW_DECAY
HYENA_MAX_DECAY = math.log(HYENA_DECAY_TARGET) / HYENA_FAST_DECAY
HYENA_SHIFT = 0.05
EPS = 1e-6
NEG_INF = -1e30

kernel_name = "hybrid_hyena_shortconv_swa_macaron"


def rms_norm(x, g):
    xf = x.astype(jnp.float32)
    y = xf * lax.rsqrt(jnp.mean(xf * xf, axis=-1, keepdims=True) + EPS)
    return (y * g.astype(jnp.float32)).astype(x.dtype)


def swiglu(x, w_gate, w_up, w_down):
    return (jax.nn.silu(x @ w_gate) * (x @ w_up)) @ w_down


def centered_conv3(u, w):
    up = jnp.pad(u, ((0, 0), (1, 1), (0, 0)))
    return up[:, :-2] * w[0] + up[:, 1:-1] * w[1] + up[:, 2:] * w[2]


def hyena_filter_kernel(L, w1, b1, w2, b2, w3, b3, freq, w_out):
    f32 = jnp.float32
    n = jnp.arange(L, dtype=f32)
    t = n / float(max(L - 1, 1))
    bands = jnp.linspace(1e-4, FILTER_BANDS - 1, FILTER_BANDS, dtype=f32)
    ang = (2.0 * math.pi / L) * n[:, None] * bands[None, :]
    z = jnp.concatenate([t[:, None], jnp.cos(ang), jnp.sin(ang)], axis=-1)
    fr = freq.astype(f32)
    h = jnp.sin(fr * (z @ w1.astype(f32) + b1.astype(f32)))
    h = jnp.sin(fr * (h @ w2.astype(f32) + b2.astype(f32)))
    h = jnp.sin(fr * (h @ w3.astype(f32) + b3.astype(f32)))
    h = h @ w_out.astype(f32)
    deltas = jnp.abs(jnp.linspace(HYENA_MIN_DECAY, HYENA_MAX_DECAY, D_HYENA, dtype=f32))
    window = jnp.exp(-t[:, None] * deltas[None, :]) + HYENA_SHIFT
    h_fwd = h[:, :D_HYENA] * window
    h_bwd = h[:, D_HYENA:] * window
    return jnp.concatenate([h_fwd, jnp.zeros((1, D_HYENA), f32), h_bwd[:0:-1]], axis=0)


def two_sided_fftconv(u, kernel):
    L = u.shape[1]
    uf = jnp.fft.rfft(u.astype(jnp.float32), n=2 * L, axis=1)
    kf = jnp.fft.rfft(kernel, n=2 * L, axis=0)
    return jnp.fft.irfft(uf * kf[None], n=2 * L, axis=1)[:, :L]


def hyena_mixer(p, short_w, short_b, bias_d, w1, b1, w2, b2, w3, b3, freq, w_out):
    L = p.shape[1]
    u = centered_conv3(p, short_w) + short_b
    x0, x1, v = jnp.split(u, 3, axis=-1)
    zv = v * x1
    kernel = hyena_filter_kernel(L, w1, b1, w2, b2, w3, b3, freq, w_out)
    y = two_sided_fftconv(zv, kernel) + zv.astype(jnp.float32) * bias_d.astype(jnp.float32)
    return x0 * y.astype(x0.dtype)


def short_conv_mixer(p, conv_w):
    gb, gc, hv = jnp.split(p, 3, axis=-1)
    return gb * centered_conv3(gc * hv, conv_w)


def band_blocks(t, nb):
    tp = jnp.pad(t, ((0, 0), (BLOCK, BLOCK), (0, 0), (0, 0)))
    tp = tp.reshape(t.shape[0], nb + 2, BLOCK, t.shape[2], t.shape[3])
    return jnp.concatenate([tp[:, :-2], tp[:, 1:-1], tp[:, 2:]], axis=2)


def windowed_gqa(q, k, v, q_g, k_g, sink):
    f32 = jnp.float32
    Bsz, L, _ = q.shape
    nb = L // BLOCK
    q = rms_norm(q.reshape(Bsz, L, N_HEADS, HEAD_DIM), q_g)
    k = rms_norm(k.reshape(Bsz, L, N_KV_HEADS, HEAD_DIM), k_g)
    v = v.reshape(Bsz, L, N_KV_HEADS, HEAD_DIM)
    qb = q.reshape(Bsz, nb, BLOCK, N_KV_HEADS, GROUP, HEAD_DIM).astype(f32)
    kb = band_blocks(k, nb).astype(f32)
    vb = band_blocks(v, nb).astype(f32)
    scores = jnp.einsum("bnqhgd,bnshd->bnhgqs", qb, kb) * (HEAD_DIM ** -0.5)
    qpos = jnp.arange(nb)[:, None] * BLOCK + jnp.arange(BLOCK)[None, :]
    kpos = (jnp.arange(nb)[:, None] - 1) * BLOCK + jnp.arange(3 * BLOCK)[None, :]
    dist = jnp.abs(qpos[:, :, None] - kpos[:, None, :])
    valid = (dist <= WINDOW) & (kpos[:, None, :] >= 0) & (kpos[:, None, :] < L)
    slopes = jnp.exp2(-8.0 * jnp.arange(1, N_HEADS + 1, dtype=f32) / N_HEADS)
    slopes = slopes.reshape(N_KV_HEADS, GROUP)[None, None, :, :, None, None]
    logits = scores - slopes * dist.astype(f32)[None, :, None, None]
    logits = jnp.where(valid[None, :, None, None], logits, NEG_INF)
    sink_b = sink.astype(f32).reshape(N_KV_HEADS, GROUP)[None, None, :, :, None]
    m = jnp.maximum(jnp.max(logits, axis=-1), sink_b)
    p = jnp.exp(logits - m[..., None])
    denom = jnp.sum(p, axis=-1) + jnp.exp(sink_b - m)
    probs = p / denom[..., None]
    o = jnp.einsum("bnhgqs,bnshd->bnqhgd", probs, vb)
    return o.reshape(Bsz, L, D_ATTN).astype(q.dtype)


def setup_inputs(seed: int = 0) -> dict:
    key = jax.random.key(seed)
    ks = jax.random.split(key, 28)
    f32 = jnp.float32

    def nrm(k, shape, scale):
        return scale * jax.random.normal(k, shape, f32)

    def gain(k, shape):
        return 1.0 + 0.02 * jax.random.normal(k, shape, f32)

    L_ = DEPTH
    return {
        "x": nrm(ks[0], (BATCH, SEQ, D_MODEL), 1.0),
        "norm_ffn1": gain(ks[1], (L_, D_MODEL)),
        "ffn1_w_gate": nrm(ks[2], (L_, D_MODEL, D_FF), D_MODEL ** -0.5),
        "ffn1_w_up": nrm(ks[3], (L_, D_MODEL, D_FF), D_MODEL ** -0.5),
        "ffn1_w_down": nrm(ks[4], (L_, D_FF, D_MODEL), D_FF ** -0.5),
        "norm_mix": gain(ks[5], (L_, D_MODEL)),
        "w_in": nrm(ks[6], (L_, D_MODEL, D_IN_PROJ), D_MODEL ** -0.5),
        "hyena_short_w": nrm(ks[7], (L_, CONV_WIDTH, 3 * D_HYENA), CONV_WIDTH ** -0.5),
        "hyena_short_b": nrm(ks[8], (L_, 3 * D_HYENA), 0.02),
        "filt_w1": nrm(ks[9], (L_, FILTER_EMB_DIM, FILTER_HIDDEN), FILTER_EMB_DIM ** -0.5),
        "filt_b1": nrm(ks[10], (L_, FILTER_HIDDEN), 0.1),
        "filt_w2": nrm(ks[11], (L_, FILTER_HIDDEN, FILTER_HIDDEN), FILTER_HIDDEN ** -0.5),
        "filt_b2": nrm(ks[12], (L_, FILTER_HIDDEN), 0.1),
        "filt_w3": nrm(ks[13], (L_, FILTER_HIDDEN, FILTER_HIDDEN), FILTER_HIDDEN ** -0.5),
        "filt_b3": nrm(ks[14], (L_, FILTER_HIDDEN), 0.1),
        "filt_freq": gain(ks[15], (L_, FILTER_HIDDEN)),
        "filt_w_out": nrm(ks[16], (L_, FILTER_HIDDEN, 2 * D_HYENA), FILTER_HIDDEN ** -0.5),
        "hyena_bias": nrm(ks[17], (L_, D_HYENA), 1.0),
        "sconv_w": nrm(ks[18], (L_, CONV_WIDTH, D_SCONV), CONV_WIDTH ** -0.5),
        "q_norm_g": gain(ks[19], (L_, HEAD_DIM)),
        "k_norm_g": gain(ks[20], (L_, HEAD_DIM)),
        "attn_sink": nrm(ks[21], (L_, N_HEADS), 0.5),
        "mix_out_g": gain(ks[22], (L_, D_MIX)),
        "w_out": nrm(ks[23], (L_, D_MIX, D_MODEL), D_MIX ** -0.5),
        "norm_ffn2": gain(ks[24], (L_, D_MODEL)),
        "ffn2_w_gate": nrm(ks[25], (L_, D_MODEL, D_FF), D_MODEL ** -0.5),
        "ffn2_w_up": nrm(ks[26], (L_, D_MODEL, D_FF), D_MODEL ** -0.5),
        "ffn2_w_down": nrm(ks[27], (L_, D_FF, D_MODEL), D_FF ** -0.5),
    }


def reference(x, norm_ffn1, ffn1_w_gate, ffn1_w_up, ffn1_w_down, norm_mix, w_in,
              hyena_short_w, hyena_short_b, filt_w1, filt_b1, filt_w2, filt_b2,
              filt_w3, filt_b3, filt_freq, filt_w_out, hyena_bias, sconv_w,
              q_norm_g, k_norm_g, attn_sink, mix_out_g, w_out, norm_ffn2,
              ffn2_w_gate, ffn2_w_up, ffn2_w_down):
    for l in range(DEPTH):
        h = rms_norm(x, norm_ffn1[l])
        x = x + 0.5 * swiglu(h, ffn1_w_gate[l], ffn1_w_up[l], ffn1_w_down[l])

        h = rms_norm(x, norm_mix[l])
        proj = h @ w_in[l]
        p_hy = proj[..., :SPLIT_SC]
        p_sc = proj[..., SPLIT_SC:SPLIT_Q]
        q = proj[..., SPLIT_Q:SPLIT_K]
        k = proj[..., SPLIT_K:SPLIT_V]
        v = proj[..., SPLIT_V:]
        y_hy = hyena_mixer(p_hy, hyena_short_w[l], hyena_short_b[l], hyena_bias[l],
                           filt_w1[l], filt_b1[l], filt_w2[l], filt_b2[l],
                           filt_w3[l], filt_b3[l], filt_freq[l], filt_w_out[l])
        y_sc = short_conv_mixer(p_sc, sconv_w[l])
        y_at = windowed_gqa(q, k, v, q_norm_g[l], k_norm_g[l], attn_sink[l])
        g = mix_out_g[l]
        y = jnp.concatenate([
            rms_norm(y_hy, g[:D_HYENA]),
            rms_norm(y_sc, g[D_HYENA:D_HYENA + D_SCONV]),
            rms_norm(y_at, g[D_HYENA + D_SCONV:]),
        ], axis=-1)
        x = x + y @ w_out[l]

        h = rms_norm(x, norm_ffn2[l])
        x = x + 0.5 * swiglu(h, ffn2_w_gate[l], ffn2_w_up[l], ffn2_w_down[l])
    return x
```

```cpp
#include <hip/hip_runtime.h>
#include <hip/hip_cooperative_groups.h>
#include <cstdio>
namespace cg = cooperative_groups;
#include <hip/hip_runtime.h>
namespace pg8 {
#define PG8_LAS __attribute__((address_space(3)))
typedef unsigned short bf16_t;
typedef short bf16x8 __attribute__((ext_vector_type(8)));
typedef float f32x4 __attribute__((ext_vector_type(4)));
typedef unsigned u32x4 __attribute__((ext_vector_type(4)));
constexpr int BM = 256, BK = 64, HALF = 128, HTB = HALF * BK * 2  , STAGE_BYTES = 8 * HTB, NXCD = 8, WGM = 8;

__host__ __device__ __forceinline__ int lds_byte(int r, int c) { const int st = (r >> 4) * 2 + (c >> 5), rr = r & 15, cc = c & 31, ob = rr * 64 + cc * 2; return st * 1024 + (ob ^ (((ob >> 9) & 1) << 5)); }
__host__ __device__ __forceinline__ void stage_rc(int b, int& R, int& C) { const int st = b / 1024, sb = b % 1024, swz = sb ^ (((sb >> 9) & 1) << 5); R = (st >> 1) * 16 + swz / 64; C = (st & 1) * 32 + (swz % 64) / 2; }
__host__ __device__ __forceinline__ int perm32(int rho) { const int n = rho >> 4, i = rho & 15; return 8 * (i >> 2) + 4 * n + (i & 3); }

struct Unit { int pm, pn; };
struct Gemm { const bf16_t* A; const bf16_t* Bt; int M, N, K; };

struct StaticOrder {
    int nM, nN, nwg, G, c;
    __host__ __device__ void init(int M, int N, int G_, int c_) { nM = M / BM; nN = N / BM; nwg = nM * nN; G = G_; c = c_; }
    __host__ __device__ bool next(int i, Unit& u) const {
        const long L = (long)i * G + c; if (L >= nwg) return false;
        int wgid = (int)L; { const int q = nwg / NXCD, r = nwg % NXCD, xcd = wgid % NXCD, off = wgid / NXCD; wgid = (xcd < r ? xcd * (q + 1) : r * (q + 1) + (xcd - r) * q) + off; }
        const int nig = WGM * nN, gid = wgid / nig, fm = gid * WGM, gsz = (nM - fm) < WGM ? (nM - fm) : WGM;
        u.pm = fm + ((wgid % nig) % gsz); u.pn = (wgid % nig) / gsz; return true;
    }
    __device__ __forceinline__ void a_ready(const Unit&) const {}
    __device__ __forceinline__ void done(const Unit&) const {}
};
__device__ __forceinline__ unsigned cvt_pk_bf16(float lo, float hi) { unsigned r; asm volatile("v_cvt_pk_bf16_f32 %0, %1, %2" : "=v"(r) : "v"(lo), "v"(hi)); return r; }

struct EpiRes {
    static constexpr bool PERM = false, AFTER_DRAIN = false;
    const float* src; float* out; int ldc; float scale;
    __device__ __forceinline__ void operator()(const f32x4 (&acc)[2][2][4][2], const Unit& u, int wr, int wc, int fr, int fq) const {
        const int row0 = u.pm * BM + wr * 64 + fr, col0 = u.pn * BM + wc * 32 + 4 * fq;
#pragma unroll
        for (int ai = 0; ai < 2; ++ai)
#pragma unroll
            for (int m = 0; m < 4; ++m) { const size_t off = (size_t)(row0 + ai * HALF + m * 16) * ldc + col0;
                f32x4 s[2][2];
#pragma unroll
                for (int bj = 0; bj < 2; ++bj)
#pragma unroll
                    for (int n = 0; n < 2; ++n) s[bj][n] = *(const f32x4*)(src + off + bj * HALF + n * 16);
#pragma unroll
                for (int bj = 0; bj < 2; ++bj)
#pragma unroll
                    for (int n = 0; n < 2; ++n) *(f32x4*)(out + off + bj * HALF + n * 16) = s[bj][n] + acc[ai][bj][m][n] * scale;
                asm volatile("" ::: "memory"); }
    }
};
struct EpiB16 {
    static constexpr bool PERM = true, AFTER_DRAIN = false;
    bf16_t* O; int ldc;
    __device__ __forceinline__ void operator()(const f32x4 (&acc)[2][2][4][2], const Unit& u, int wr, int wc, int fr, int fq) const {
        const int row0 = u.pm * BM + wr * 64 + fr, col0 = u.pn * BM + wc * 32 + 8 * fq;
#pragma unroll
        for (int ai = 0; ai < 2; ++ai)
#pragma unroll
            for (int m = 0; m < 4; ++m) { bf16_t* rowp = O + (size_t)(row0 + ai * HALF + m * 16) * ldc + col0;
#pragma unroll
                for (int bj = 0; bj < 2; ++bj) { const f32x4 v0 = acc[ai][bj][m][0], v1 = acc[ai][bj][m][1];
                    u32x4 w; w.x = cvt_pk_bf16(v0[0], v0[1]); w.y = cvt_pk_bf16(v0[2], v0[3]); w.z = cvt_pk_bf16(v1[0], v1[1]); w.w = cvt_pk_bf16(v1[2], v1[3]);
                    *(u32x4*)(rowp + bj * HALF) = w; } }
    }
};
__device__ __forceinline__ float silu_mul(float g, float u) { return g * u * __builtin_amdgcn_rcpf(1.0f + __builtin_amdgcn_exp2f(-1.44269504089f * g)); }
struct EpiGU {
    static constexpr bool PERM = true, AFTER_DRAIN = false;
    bf16_t* O; int ldc;
    __device__ __forceinline__ void operator()(const f32x4 (&acc)[2][2][4][2], const Unit& u, int wr, int wc, int fr, int fq) const {
        const int row0 = u.pm * BM + wr * 64 + fr, col0 = u.pn * HALF + wc * 32 + 8 * fq;
#pragma unroll
        for (int ai = 0; ai < 2; ++ai)
#pragma unroll
            for (int m = 0; m < 4; ++m) { bf16_t* rowp = O + (size_t)(row0 + ai * HALF + m * 16) * ldc + col0;
                const f32x4 g0 = acc[ai][0][m][0], g1 = acc[ai][0][m][1], u0 = acc[ai][1][m][0], u1 = acc[ai][1][m][1];
                u32x4 w;
                w.x = cvt_pk_bf16(silu_mul(g0[0], u0[0]), silu_mul(g0[1], u0[1])); w.y = cvt_pk_bf16(silu_mul(g0[2], u0[2]), silu_mul(g0[3], u0[3]));
                w.z = cvt_pk_bf16(silu_mul(g1[0], u1[0]), silu_mul(g1[1], u1[1])); w.w = cvt_pk_bf16(silu_mul(g1[2], u1[2]), silu_mul(g1[3], u1[3]));
                *(u32x4*)rowp = w; }
    }
};

template <class Epi, class Sched, bool STAMP = false>
__device__ __forceinline__ void gemm_phase(PG8_LAS unsigned char* lds, const Gemm g, const Sched& S, const Epi& E, unsigned long long* stamps) {
    const int tid = threadIdx.x, wid = __builtin_amdgcn_readfirstlane(tid >> 6), lane = tid & 63, wr = wid >> 2, wc = wid & 3, fr = lane & 15, fq = lane >> 4;
    const int K = g.K, nt = K / BK;
    int ts_lo = 0, ts_hi = 0, nts = 0; const unsigned long long rt_entry = STAMP ? (unsigned long long)wall_clock64() : 0ull;
#define PG8_STAMP() do { if (STAMP && wid == 0 && nts < 64) { const unsigned long long _c = (unsigned long long)clock64(); \
        ts_lo = (lane == nts) ? (int)(unsigned)_c : ts_lo; ts_hi = (lane == nts) ? (int)(unsigned)(_c >> 32) : ts_hi; ++nts; } } while (0)
    PG8_STAMP();
    unsigned voffA[2], voffB[2];
#pragma unroll
    for (int i = 0; i < 2; ++i) { int R, C; stage_rc(tid * 16 + i * 8192, R, C); const int Rb = Epi::PERM ? ((R & ~31) + perm32(R & 31)) : R;
        voffA[i] = (unsigned)(R * K + C) * 2u; voffB[i] = (unsigned)(Rb * K + C) * 2u; }
    const size_t kstep = (size_t)(BK * 2);
    const size_t hstep = (size_t)HALF * K * 2;
    const size_t tstep = 2 * hstep;
    const unsigned ldsw = (unsigned)wid * 1024u;
    const int aoff = lds_byte(wr * 64 + fr, fq * 8), boff = lds_byte(wc * 32 + fr, fq * 8);
#define PG8_SA(b, h) (((b) * 2 + (h)) * HTB)
#define PG8_SB(b, h) ((4 + (b) * 2 + (h)) * HTB)
#define PG8_STAGE(bufoff, gbase, voff) do { _Pragma("unroll") for (int _i = 0; _i < 2; ++_i) \
        __builtin_amdgcn_global_load_lds((const unsigned*)((const char*)(gbase) + (voff)[_i]), (PG8_LAS unsigned*)(lds + (bufoff) + ldsw + _i * 8192), 16, 0, 0); } while (0)
#define PG8_LDA(dst, b, h) do { _Pragma("unroll") for (int m = 0; m < 4; ++m) _Pragma("unroll") for (int k = 0; k < 2; ++k) dst[m][k] = *(const PG8_LAS bf16x8*)(lds + PG8_SA(b, h) + aoff + m * 2048 + k * 1024); } while (0)
#define PG8_LDB(dst, b, h) do { _Pragma("unroll") for (int n = 0; n < 2; ++n) _Pragma("unroll") for (int k = 0; k < 2; ++k) dst[n][k] = *(const PG8_LAS bf16x8*)(lds + PG8_SB(b, h) + boff + n * 2048 + k * 1024); } while (0)
#define PG8_MMA(ai, bj, At, Bt) do { __builtin_amdgcn_s_setprio(1); _Pragma("unroll") for (int m = 0; m < 4; ++m) _Pragma("unroll") for (int n = 0; n < 2; ++n) _Pragma("unroll") for (int k = 0; k < 2; ++k) \
        acc[ai][bj][m][n] = __builtin_amdgcn_mfma_f32_16x16x32_bf16(Bt[n][k], At[m][k], acc[ai][bj][m][n], 0, 0, 0); __builtin_amdgcn_s_setprio(0); } while (0)
#define PG8_WAIT_V(n) asm volatile("s_waitcnt vmcnt(" #n ")" ::: "memory")
#define PG8_WAIT_L(n) asm volatile("s_waitcnt lgkmcnt(" #n ")" ::: "memory")
#define PG8_BAR __builtin_amdgcn_s_barrier()
#define PG8_SCHED __builtin_amdgcn_sched_barrier(0)
    Unit cur, nxt; int ui = 0;
    if (!S.next(0, cur)) return;
    f32x4 acc[2][2][4][2];
#pragma unroll
    for (int a = 0; a < 2; ++a)
#pragma unroll
        for (int b = 0; b < 2; ++b)
#pragma unroll
            for (int m = 0; m < 4; ++m)
#pragma unroll
                for (int n = 0; n < 2; ++n) acc[a][b][m][n] = (f32x4){0.f, 0.f, 0.f, 0.f};
    bf16x8 At[4][2], B0[2][2], B1[2][2];
    const char* cA = (const char*)g.A + (size_t)cur.pm * tstep; const char* cB = (const char*)g.Bt + (size_t)cur.pn * tstep;
    S.a_ready(cur);
    PG8_STAGE(PG8_SB(0, 0), cB, voffB); PG8_STAGE(PG8_SA(0, 0), cA, voffA); PG8_STAGE(PG8_SB(0, 1), cB + hstep, voffB); PG8_STAGE(PG8_SA(0, 1), cA + hstep, voffA);
    if (wr == 1) PG8_BAR;
    PG8_WAIT_V(4); PG8_BAR;
    PG8_STAGE(PG8_SB(1, 0), cB + kstep, voffB); PG8_STAGE(PG8_SA(1, 0), cA + kstep, voffA); PG8_STAGE(PG8_SB(1, 1), cB + hstep + kstep, voffB);
    PG8_WAIT_V(6); PG8_BAR;
    PG8_STAMP();
    for (;;) {
        const bool has_next = S.next(ui + 1, nxt);
        const char* nA = has_next ? (const char*)g.A + (size_t)nxt.pm * tstep : cA; const char* nB = has_next ? (const char*)g.Bt + (size_t)nxt.pn * tstep : cB;
        for (int t = 0; t < nt; t += 2) {
            const bool last = (t == nt - 2);
            const char* a1 = cA + (size_t)(t + 1) * kstep;
            const char* a2 = last ? nA : cA + (size_t)(t + 2) * kstep; const char* b2 = last ? nB : cB + (size_t)(t + 2) * kstep;
            const char* a3 = a2 + kstep; const char* b3 = b2 + kstep;
            if (last && has_next) S.a_ready(nxt);
            PG8_LDB(B0, 0, 0); PG8_SCHED; PG8_LDA(At, 0, 0); PG8_STAGE(PG8_SA(1, 1), a1 + hstep, voffA);
            PG8_WAIT_L(8); PG8_BAR; PG8_WAIT_L(0); PG8_MMA(0, 0, At, B0); PG8_BAR; PG8_SCHED;
            PG8_LDB(B1, 0, 1); PG8_STAGE(PG8_SB(0, 0), b2, voffB);
            PG8_BAR; PG8_WAIT_L(0); PG8_MMA(0, 1, At, B1); PG8_BAR;
            PG8_LDA(At, 0, 1); PG8_STAGE(PG8_SA(0, 0), a2, voffA);
            PG8_BAR; PG8_WAIT_L(0); PG8_MMA(1, 0, At, B0); PG8_BAR; PG8_SCHED;
            PG8_STAGE(PG8_SB(0, 1), b2 + hstep, voffB);
            PG8_WAIT_V(6); PG8_BAR; PG8_MMA(1, 1, At, B1); PG8_BAR;
            PG8_LDB(B0, 1, 0); PG8_SCHED; PG8_LDA(At, 1, 0); PG8_STAGE(PG8_SA(0, 1), a2 + hstep, voffA);
            PG8_WAIT_L(8); PG8_BAR; PG8_WAIT_L(0); PG8_MMA(0, 0, At, B0); PG8_BAR; PG8_SCHED;
            PG8_LDB(B1, 1, 1); PG8_STAGE(PG8_SB(1, 0), b3, voffB);
            PG8_BAR; PG8_WAIT_L(0); PG8_MMA(0, 1, At, B1); PG8_BAR;
            PG8_LDA(At, 1, 1); PG8_STAGE(PG8_SA(1, 0), a3, voffA);
            PG8_BAR; PG8_WAIT_L(0); PG8_MMA(1, 0, At, B0); PG8_BAR; PG8_SCHED;
            PG8_STAGE(PG8_SB(1, 1), b3 + hstep, voffB);
            PG8_WAIT_V(6); PG8_BAR; PG8_MMA(1, 1, At, B1); PG8_BAR;
        }
        PG8_STAMP();
        if constexpr (!Epi::AFTER_DRAIN) { E(acc, cur, wr, wc, fr, fq); S.done(cur); }
        PG8_STAMP();
        if (!has_next) break;
#pragma unroll
        for (int a = 0; a < 2; ++a)
#pragma unroll
            for (int b = 0; b < 2; ++b)
#pragma unroll
                for (int m = 0; m < 4; ++m)
#pragma unroll
                    for (int n = 0; n < 2; ++n) acc[a][b][m][n] = (f32x4){0.f, 0.f, 0.f, 0.f};
        cur = nxt; cA = nA; cB = nB; ++ui;
    }
    PG8_WAIT_V(0);
    if (wr == 0) PG8_BAR;
    PG8_BAR;
    if constexpr (Epi::AFTER_DRAIN) { E.fused(acc, cur, wr, wc, fr, fq, lds, wid, lane); S.done(cur); }
    PG8_STAMP();
    if (STAMP && wid == 0) { stamps[lane] = lane < nts ? (((unsigned long long)(unsigned)ts_hi << 32) | (unsigned)ts_lo) : 0ull;
        if (lane == 62) stamps[62] = rt_entry; if (lane == 63) stamps[63] = (unsigned long long)wall_clock64(); }
#undef PG8_STAMP
#undef PG8_SA
#undef PG8_SB
#undef PG8_STAGE
#undef PG8_LDA
#undef PG8_LDB
#undef PG8_MMA
#undef PG8_WAIT_V
#undef PG8_WAIT_L
#undef PG8_BAR
#undef PG8_SCHED
}
}

#define LAS __attribute__((address_space(3)))
typedef unsigned short bf16_t;
typedef short bf16x8 __attribute__((ext_vector_type(8)));
typedef float f32x4 __attribute__((ext_vector_type(4)));
typedef unsigned u32x4 __attribute__((ext_vector_type(4)));
typedef unsigned u32x2 __attribute__((ext_vector_type(2)));

constexpr int MTOK = 16384, DM = 2048, DFF = 5632, NPROJ = 4608, SEQ = 4096, NB = 4;
constexpr int NTHREADS = 512;
constexpr int LDS_BYTES = 131072;
constexpr float EPS = 1e-6f;

constexpr size_t SZ_WGU = (size_t)2 * DFF * DM * 2, SZ_WDN = (size_t)DM * DFF * 2, SZ_WIN = (size_t)NPROJ * DM * 2, SZ_WOUT = (size_t)DM * DM * 2;
constexpr size_t WS_WGU = 0;
constexpr size_t WS_WDN = WS_WGU + 4 * SZ_WGU;
constexpr size_t WS_WIN = WS_WDN + 4 * SZ_WDN;
constexpr size_t WS_WOUT = WS_WIN + 2 * SZ_WIN;
constexpr size_t WS_KF = WS_WOUT + 2 * SZ_WOUT;
constexpr size_t WS_HB = WS_KF + (size_t)2 * 512 * 8192 * 2;
constexpr size_t WS_UN = WS_HB + (size_t)MTOK * DM * 2;
constexpr size_t WS_ACT = WS_UN;
constexpr size_t WS_PB = WS_UN;
constexpr size_t WS_ZVT = WS_PB + (size_t)MTOK * NPROJ * 2;
constexpr size_t WS_CONVT = WS_ZVT + (size_t)512 * 4 * 4096 * 2;
constexpr size_t WS_YAT = WS_CONVT + (size_t)512 * 4 * 4096 * 4;
constexpr size_t WS_END = WS_YAT + (size_t)MTOK * 1024 * 2;
static_assert(WS_END - WS_UN >= (size_t)MTOK * DFF * 2, "union region must hold ACT");

struct Params { const float* in[28]; float* out; unsigned char* ws; int ph_lo, ph_hi; };

__device__ __forceinline__ float bf2f(unsigned short b) { return __uint_as_float(((unsigned)b) << 16); }
__device__ __forceinline__ float bflo(unsigned w) { return __uint_as_float(w << 16); }
__device__ __forceinline__ float bfhi(unsigned w) { return __uint_as_float(w & 0xffff0000u); }
__device__ __forceinline__ unsigned pk2(float lo, float hi) { return pg8::cvt_pk_bf16(lo, hi); }
__device__ __forceinline__ float wave_sum(float v) {
#pragma unroll
    for (int o = 32; o >= 1; o >>= 1) v += __shfl_xor(v, o);
    return v;
}

constexpr int CV_TK = 64, CV_TN = 128, CV_LD = 129;
struct CvJob { const float* src; const float* gain; bf16_t* dst; int K, N, mode; };
constexpr int CV_T_GU = (DM / CV_TK) * (DFF / CV_TN), CV_T_DN = (DFF / CV_TK) * (DM / CV_TN), CV_T_IN = (DM / CV_TK) * (NPROJ / CV_TN), CV_T_OUT = (DM / CV_TK) * (DM / CV_TN);
constexpr int CV_PER_LAYER = 4 * CV_T_GU + 2 * CV_T_DN + CV_T_IN + CV_T_OUT;
__device__ __forceinline__ void cv_decode(const Params& p, int gt, CvJob& j, int& tk, int& tn) {
    const int l = gt / CV_PER_LAYER; int r = gt - l * CV_PER_LAYER;
    unsigned char* ws = p.ws;
    int tiles_n;
    if (r < 4 * CV_T_GU) { const int w = r / CV_T_GU; r -= w * CV_T_GU; const int f = w >> 1, up = w & 1;
        j.src = p.in[(f ? 25 : 2) + up] + (size_t)l * DM * DFF; j.gain = p.in[f ? 24 : 1] + l * DM; j.dst = (bf16_t*)(ws + WS_WGU + (size_t)(l * 2 + f) * SZ_WGU); j.K = DM; j.N = DFF; j.mode = 1 + up; tiles_n = DFF / CV_TN; }
    else if ((r -= 4 * CV_T_GU) < 2 * CV_T_DN) { const int f = r / CV_T_DN; r -= f * CV_T_DN;
        j.src = p.in[f ? 27 : 4] + (size_t)l * DFF * DM; j.gain = nullptr; j.dst = (bf16_t*)(ws + WS_WDN + (size_t)(l * 2 + f) * SZ_WDN); j.K = DFF; j.N = DM; j.mode = 0; tiles_n = DM / CV_TN; }
    else if ((r -= 2 * CV_T_DN) < CV_T_IN) {
        j.src = p.in[6] + (size_t)l * DM * NPROJ; j.gain = p.in[5] + l * DM; j.dst = (bf16_t*)(ws + WS_WIN + (size_t)l * SZ_WIN); j.K = DM; j.N = NPROJ; j.mode = 0; tiles_n = NPROJ / CV_TN; }
    else { r -= CV_T_IN;
        j.src = p.in[23] + (size_t)l * DM * DM; j.gain = p.in[22] + l * DM; j.dst = (bf16_t*)(ws + WS_WOUT + (size_t)l * SZ_WOUT); j.K = DM; j.N = DM; j.mode = 0; tiles_n = DM / CV_TN; }
    tk = r / tiles_n; tn = r - tk * tiles_n;
}
__device__ __forceinline__ void cv_load(const Params& p, int gt, f32x4 (&v)[4]) {
    CvJob j; int tk, tn; cv_decode(p, gt, j, tk, tn);
    const int tid = threadIdx.x;
#pragma unroll
    for (int it = 0; it < 4; ++it) { const int idx = tid + it * NTHREADS, k = idx >> 5, n4 = idx & 31;
        f32x4 x = __builtin_nontemporal_load((const f32x4*)(j.src + (size_t)(tk * CV_TK + k) * j.N + tn * CV_TN + n4 * 4));
        if (j.gain) x = x * j.gain[tk * CV_TK + k];
        v[it] = x; }
}
__device__ __forceinline__ void phase_convert(const Params& p, LAS unsigned char* lds) {
    LAS float* T = (LAS float*)lds;
    const int tid = threadIdx.x, G = gridDim.x;
    const int total = 2 * CV_PER_LAYER;
    int gt = blockIdx.x;
    f32x4 v[4];
    if (gt < total) cv_load(p, gt, v);
    for (; gt < total; gt += G) {
        __syncthreads();
#pragma unroll
        for (int it = 0; it < 4; ++it) { const int idx = tid + it * NTHREADS, k = idx >> 5, n4 = idx & 31;
#pragma unroll
            for (int e = 0; e < 4; ++e) T[k * CV_LD + n4 * 4 + e] = v[it][e]; }
        CvJob j; int tk, tn; cv_decode(p, gt, j, tk, tn);
        if (gt + G < total) cv_load(p, gt + G, v);
        __syncthreads();
        const int n = tid >> 2, kc = tid & 3;
        unsigned w[8];
#pragma unroll
        for (int i = 0; i < 8; ++i) w[i] = pk2(T[(kc * 16 + 2 * i) * CV_LD + n], T[(kc * 16 + 2 * i + 1) * CV_LD + n]);
        const int ng = tn * CV_TN + n;
        const int row = j.mode == 0 ? ng : ((ng >> 7) * 256 + (j.mode == 2 ? 128 : 0) + (ng & 127));
        bf16_t* d = j.dst + (size_t)row * j.K + tk * CV_TK + kc * 16;
        *(u32x4*)d = (u32x4){w[0], w[1], w[2], w[3]};
        *(u32x4*)(d + 8) = (u32x4){w[4], w[5], w[6], w[7]};
    }
    __syncthreads();
}

__device__ __forceinline__ void phase_filter(const Params& p, LAS unsigned char* lds) {
    LAS float* zs = (LAS float*)lds;
    LAS float* h1 = zs + 16 * 33;
    LAS float* h2 = h1 + 16 * 64;
    LAS float* h3 = h2 + 16 * 64;
    const int tid = threadIdx.x, G = gridDim.x;
    bf16_t* KF = (bf16_t*)(p.ws + WS_KF);
    for (int u = blockIdx.x; u < 512; u += G) {
        const int l = u >> 8, n0 = (u & 255) * 16;
        const float* w1 = p.in[9] + l * 33 * 64; const float* b1 = p.in[10] + l * 64;
        const float* w2 = p.in[11] + l * 64 * 64; const float* b2 = p.in[12] + l * 64;
        const float* w3 = p.in[13] + l * 64 * 64; const float* b3 = p.in[14] + l * 64;
        const float* fr = p.in[15] + l * 64; const float* wo = p.in[16] + (size_t)l * 64 * 1024;
        __syncthreads();
        for (int idx = tid; idx < 16 * 33; idx += NTHREADS) { const int pp = idx / 33, e = idx - pp * 33; const float n = (float)(n0 + pp);
            float val;
            if (e == 0) val = n / 4095.0f;
            else { const int k = (e - 1) & 15; const float band = 1e-4f + (float)k * ((15.0f - 1e-4f) / 15.0f); const float ang = (6.283185307179586f / 4096.0f) * n * band;
                val = (e <= 16) ? cosf(ang) : sinf(ang); }
            zs[idx] = val; }
        __syncthreads();
        for (int idx = tid; idx < 16 * 64; idx += NTHREADS) { const int pp = idx >> 6, j = idx & 63; float a = b1[j];
            for (int e = 0; e < 33; ++e) a += zs[pp * 33 + e] * w1[e * 64 + j];
            h1[idx] = sinf(fr[j] * a); }
        __syncthreads();
        for (int idx = tid; idx < 16 * 64; idx += NTHREADS) { const int pp = idx >> 6, j = idx & 63; float a = b2[j];
            for (int e = 0; e < 64; ++e) a += h1[pp * 64 + e] * w2[e * 64 + j];
            h2[idx] = sinf(fr[j] * a); }
        __syncthreads();
        for (int idx = tid; idx < 16 * 64; idx += NTHREADS) { const int pp = idx >> 6, j = idx & 63; float a = b3[j];
            for (int e = 0; e < 64; ++e) a += h2[pp * 64 + e] * w3[e * 64 + j];
            h3[idx] = sinf(fr[j] * a); }
        __syncthreads();
        for (int oo = 0; oo < 2; ++oo) { const int o = tid + oo * NTHREADS; const int c = o & 511;
            float a[16];
#pragma unroll
            for (int pp = 0; pp < 16; ++pp) a[pp] = 0.f;
            for (int k = 0; k < 64; ++k) { const float w = wo[k * 1024 + o];
#pragma unroll
                for (int pp = 0; pp < 16; ++pp) a[pp] += h3[pp * 64 + k] * w; }
            const float dlo = -3.0701134573253945f, dhi = -15.350567286626973f;
            const float delta = fabsf(dlo + (float)c * ((dhi - dlo) / 511.0f));
            bf16_t* kc = KF + ((size_t)l * 512 + c) * 8192;
#pragma unroll
            for (int pp = 0; pp < 16; ++pp) { const float t = (float)(n0 + pp) / 4095.0f; a[pp] *= (expf(-t * delta) + 0.05f); }
            if (oo == 0) {
                unsigned w[8];
#pragma unroll
                for (int i = 0; i < 8; ++i) w[i] = pk2(a[2 * i], a[2 * i + 1]);
                *(u32x4*)(kc + 4096 + n0) = (u32x4){w[0], w[1], w[2], w[3]};
                *(u32x4*)(kc + 4096 + n0 + 8) = (u32x4){w[4], w[5], w[6], w[7]};
                if (n0 == 0) kc[0] = 0;
            } else {
#pragma unroll
                for (int pp = 0; pp < 16; ++pp) { const int n = n0 + pp; if (n >= 1) kc[4096 - n] = (bf16_t)(pk2(a[pp], 0.f) & 0xffffu); }
            }
        }
    }
    __syncthreads();
}

__device__ __forceinline__ void phase_rmsnorm(const float* x, bf16_t* hb) {
    const int lane = threadIdx.x & 63, wave = threadIdx.x >> 6;
    const int gw = blockIdx.x * 8 + wave, nw = gridDim.x * 8;
    for (int row = gw; row < MTOK; row += nw) {
        const float* xr = x + (size_t)row * DM;
        f32x4 v[8]; float ss = 0.f;
#pragma unroll
        for (int i = 0; i < 8; ++i) { v[i] = *(const f32x4*)(xr + i * 256 + lane * 4); ss += v[i][0] * v[i][0] + v[i][1] * v[i][1] + v[i][2] * v[i][2] + v[i][3] * v[i][3]; }
        ss = wave_sum(ss);
        const float rs = rsqrtf(ss * (1.0f / DM) + EPS);
        bf16_t* hr = hb + (size_t)row * DM;
#pragma unroll
        for (int i = 0; i < 8; ++i) *(u32x2*)(hr + i * 256 + lane * 4) = (u32x2){pk2(v[i][0] * rs, v[i][1] * rs), pk2(v[i][2] * rs, v[i][3] * rs)};
    }
}

__device__ __forceinline__ void phase_hyprep(const Params& p, int l) {
    const bf16_t* PB = (const bf16_t*)(p.ws + WS_PB); bf16_t* ZVT = (bf16_t*)(p.ws + WS_ZVT);
    const float* sw = p.in[7] + l * 3 * 1536; const float* sb = p.in[8] + l * 1536;
    const int lane = threadIdx.x & 63, wave = threadIdx.x >> 6;
    const int gw = blockIdx.x * 8 + wave, nw = gridDim.x * 8;
    for (int task = gw; task < 4096; task += nw) {
        const int tg = task >> 1, ch = task & 1; const int c = ch * 256 + lane * 4;
        const int tglob = tg * 8, b = tglob >> 12, t0 = tglob & 4095;
        f32x4 w1[3], wv[3];
#pragma unroll
        for (int j = 0; j < 3; ++j) { w1[j] = *(const f32x4*)(sw + j * 1536 + 512 + c); wv[j] = *(const f32x4*)(sw + j * 1536 + 1024 + c); }
        const f32x4 bb1 = *(const f32x4*)(sb + 512 + c), bbv = *(const f32x4*)(sb + 1024 + c);
        f32x4 r1[10], rv[10];
#pragma unroll
        for (int i = 0; i < 10; ++i) { const int t = t0 - 1 + i;
            if (t >= 0 && t < SEQ) { const bf16_t* row = PB + (size_t)(b * SEQ + t) * NPROJ;
                const u32x2 a = *(const u32x2*)(row + 512 + c), d = *(const u32x2*)(row + 1024 + c);
                r1[i] = (f32x4){bflo(a.x), bfhi(a.x), bflo(a.y), bfhi(a.y)}; rv[i] = (f32x4){bflo(d.x), bfhi(d.x), bflo(d.y), bfhi(d.y)}; }
            else { r1[i] = (f32x4){0.f, 0.f, 0.f, 0.f}; rv[i] = r1[i]; } }
        f32x4 zv[8];
#pragma unroll
        for (int i = 0; i < 8; ++i) { const f32x4 x1 = w1[0] * r1[i] + w1[1] * r1[i + 1] + w1[2] * r1[i + 2] + bb1; const f32x4 vv = wv[0] * rv[i] + wv[1] * rv[i + 1] + wv[2] * rv[i + 2] + bbv; zv[i] = x1 * vv; }
#pragma unroll
        for (int e = 0; e < 4; ++e) { const u32x4 w = (u32x4){pk2(zv[0][e], zv[1][e]), pk2(zv[2][e], zv[3][e]), pk2(zv[4][e], zv[5][e]), pk2(zv[6][e], zv[7][e])};
            *(u32x4*)(ZVT + ((size_t)(c + e) * 4 + b) * SEQ + t0) = w; }
    }
}

constexpr int HY_VS = 0, HY_ZS = 66560, HY_TMP = HY_ZS + 4 * 64 * 144;
__device__ __forceinline__ void hyena_conv_unit(LAS unsigned char* lds, const bf16_t* KFc, const bf16_t* ZVc, float* CONVc) {
    const int tid = threadIdx.x, lane = tid & 63, wid = tid >> 6, r = lane & 15, q = lane >> 4;
    const int b = wid >> 1, ib = (wid & 1) * 32;
    __syncthreads();
#pragma unroll
    for (int k = 0; k < 4; ++k) { const int idx = tid + k * NTHREADS; const int bb = idx >> 9, ch = idx & 511;
        const u32x4 v = *(const u32x4*)(ZVc + bb * SEQ + ch * 8);
        *(LAS u32x4*)(lds + HY_ZS + bb * 9216 + (ch >> 3) * 144 + (ch & 7) * 16) = v; }
    f32x4 acc[4][2];
#pragma unroll
    for (int m = 0; m < 4; ++m) { acc[m][0] = (f32x4){0.f, 0.f, 0.f, 0.f}; acc[m][1] = acc[m][0]; }
    LAS unsigned short* TMP = (LAS unsigned short*)(lds + HY_TMP);
    for (int hf = 0; hf < 2; ++hf) {
        const int xlo = hf ? -56 : -4088, cnt = hf ? 4152 : 4088;
        __syncthreads();
        for (int e = tid; e < cnt + 7; e += NTHREADS) TMP[e] = KFc[4096 + xlo - 7 + e];
        __syncthreads();
        for (int e = tid; e < cnt; e += NTHREADS) {
            unsigned w[4];
#pragma unroll
            for (int i = 0; i < 4; ++i) w[i] = (unsigned)TMP[e + 7 - 2 * i] | ((unsigned)TMP[e + 6 - 2 * i] << 16);
            *(LAS u32x4*)(lds + HY_VS + e * 16) = (u32x4){w[0], w[1], w[2], w[3]}; }
        __syncthreads();
        const int dlo = hf ? 0 : -63, dhi = hf ? 63 : -1;
        for (int d = dlo; d <= dhi; ++d) {
            const int base = 64 * d + r - 8 * q - xlo;
            bf16x8 Af[6];
#pragma unroll
            for (int bi = 0; bi < 6; ++bi) Af[bi] = *(const LAS bf16x8*)(lds + HY_VS + (base - 32 + 16 * bi) * 16);
#pragma unroll
            for (int nt = 0; nt < 2; ++nt) {
                const int i0 = ib + 16 * nt;
                if (i0 + 15 - d < 0 || i0 - d > 63) continue;
                const int j = i0 + r - d; const bool valid = (unsigned)j < 64u; const int jc = valid ? j : 0;
                bf16x8 Bf[2];
#pragma unroll
                for (int kk = 0; kk < 2; ++kk) { bf16x8 t = *(const LAS bf16x8*)(lds + HY_ZS + b * 9216 + jc * 144 + kk * 64 + q * 16);
                    if (!valid) t = (bf16x8){0, 0, 0, 0, 0, 0, 0, 0};
                    Bf[kk] = t; }
#pragma unroll
                for (int m = 0; m < 4; ++m)
#pragma unroll
                    for (int kk = 0; kk < 2; ++kk) acc[m][nt] = __builtin_amdgcn_mfma_f32_16x16x32_bf16(Af[m - 2 * kk + 2], Bf[kk], acc[m][nt], 0, 0, 0);
            }
        }
    }
#pragma unroll
    for (int nt = 0; nt < 2; ++nt)
#pragma unroll
        for (int m = 0; m < 4; ++m) *(f32x4*)(CONVc + b * SEQ + 64 * (ib + 16 * nt + r) + 16 * m + 4 * q) = acc[m][nt];
}

constexpr int AT_KS = 0, AT_KS_LD = 144, AT_VT = 384 * 144, AT_VT_LD = 784;
__device__ __forceinline__ void attn_unit(LAS unsigned char* lds, const bf16_t* PB, bf16_t* YAT, int u, const float* qg, const float* kg, const float* sink) {
    const int tid = threadIdx.x, lane = tid & 63, wid = tid >> 6, r = lane & 15, q = lane >> 4;
    const int b = u >> 7, nb = (u & 127) >> 2, kvh = u & 3;
    __syncthreads();
    for (int k = 0; k < 6; ++k) { const int idx = tid + k * NTHREADS; const int key = idx >> 3, ch = idx & 7; const int kpos = 128 * (nb - 1) + key;
        const bool inr = kpos >= 0 && kpos < SEQ;
        const bf16_t* src = PB + (size_t)(b * SEQ + (inr ? kpos : 0)) * NPROJ + kvh * 64 + ch * 8;
        u32x4 kv = *(const u32x4*)(src + 4096), vv = *(const u32x4*)(src + 4352);
        if (!inr) { kv = (u32x4){0u, 0u, 0u, 0u}; vv = kv; }
        float kf[8] = {bflo(kv.x), bfhi(kv.x), bflo(kv.y), bfhi(kv.y), bflo(kv.z), bfhi(kv.z), bflo(kv.w), bfhi(kv.w)};
        float ss = 0.f;
#pragma unroll
        for (int i = 0; i < 8; ++i) ss += kf[i] * kf[i];
        ss += __shfl_xor(ss, 1); ss += __shfl_xor(ss, 2); ss += __shfl_xor(ss, 4);
        const float rs = rsqrtf(ss * (1.0f / 64.0f) + EPS);
        const f32x4 g0 = *(const f32x4*)(kg + ch * 8), g1 = *(const f32x4*)(kg + ch * 8 + 4);
        const u32x4 ko = (u32x4){pk2(kf[0] * rs * g0[0], kf[1] * rs * g0[1]), pk2(kf[2] * rs * g0[2], kf[3] * rs * g0[3]), pk2(kf[4] * rs * g1[0], kf[5] * rs * g1[1]), pk2(kf[6] * rs * g1[2], kf[7] * rs * g1[3])};
        *(LAS u32x4*)(lds + AT_KS + key * AT_KS_LD + ch * 16) = ko;
        const unsigned vw[4] = {vv.x, vv.y, vv.z, vv.w};
#pragma unroll
        for (int i = 0; i < 8; ++i) *(LAS unsigned short*)(lds + AT_VT + (ch * 8 + i) * AT_VT_LD + key * 2) = (unsigned short)((i & 1) ? (vw[i >> 1] >> 16) : (vw[i >> 1] & 0xffffu));
    }
    __syncthreads();
    const int g = wid >> 1, h = kvh * 4 + g;
    const float slope = exp2f(-0.5f * (float)(h + 1)), snk = sink[h];
    for (int si = 0; si < 4; ++si) {
        const int q0 = ((wid & 1) * 4 + si) * 16; const int qpos = 128 * nb + q0 + r;
        bf16x8 Qf[2];
        {
            const bf16_t* src = PB + (size_t)(b * SEQ + qpos) * NPROJ + 3072 + h * 64 + q * 8;
            const u32x4 a0 = *(const u32x4*)(src), a1 = *(const u32x4*)(src + 32);
            float f0[8] = {bflo(a0.x), bfhi(a0.x), bflo(a0.y), bfhi(a0.y), bflo(a0.z), bfhi(a0.z), bflo(a0.w), bfhi(a0.w)};
            float f1[8] = {bflo(a1.x), bfhi(a1.x), bflo(a1.y), bfhi(a1.y), bflo(a1.z), bfhi(a1.z), bflo(a1.w), bfhi(a1.w)};
            float ss = 0.f;
#pragma unroll
            for (int i = 0; i < 8; ++i) ss += f0[i] * f0[i] + f1[i] * f1[i];
            ss += __shfl_xor(ss, 16); ss += __shfl_xor(ss, 32);
            const float rs = rsqrtf(ss * (1.0f / 64.0f) + EPS) * 0.125f;
            const f32x4 ga = *(const f32x4*)(qg + q * 8), gb = *(const f32x4*)(qg + q * 8 + 4), gc = *(const f32x4*)(qg + 32 + q * 8), gd = *(const f32x4*)(qg + 32 + q * 8 + 4);
            const u32x4 w0 = (u32x4){pk2(f0[0] * rs * ga[0], f0[1] * rs * ga[1]), pk2(f0[2] * rs * ga[2], f0[3] * rs * ga[3]), pk2(f0[4] * rs * gb[0], f0[5] * rs * gb[1]), pk2(f0[6] * rs * gb[2], f0[7] * rs * gb[3])};
            const u32x4 w1 = (u32x4){pk2(f1[0] * rs * gc[0], f1[1] * rs * gc[1]), pk2(f1[2] * rs * gc[2], f1[3] * rs * gc[3]), pk2(f1[4] * rs * gd[0], f1[5] * rs * gd[1]), pk2(f1[6] * rs * gd[2], f1[7] * rs * gd[3])};
            Qf[0] = __builtin_bit_cast(bf16x8, w0); Qf[1] = __builtin_bit_cast(bf16x8, w1);
        }
        const int kt0 = q0 >> 4;
        f32x4 S[17];
#pragma unroll
        for (int tt = 0; tt < 17; ++tt) {
            const LAS unsigned char* kp = lds + AT_KS + (16 * (kt0 + tt) + r) * AT_KS_LD + q * 16;
            const bf16x8 k0 = *(const LAS bf16x8*)kp, k1 = *(const LAS bf16x8*)(kp + 64);
            f32x4 s = __builtin_amdgcn_mfma_f32_16x16x32_bf16(k0, Qf[0], (f32x4){0.f, 0.f, 0.f, 0.f}, 0, 0, 0);
            S[tt] = __builtin_amdgcn_mfma_f32_16x16x32_bf16(k1, Qf[1], s, 0, 0, 0);
        }
        float mx = snk;
#pragma unroll
        for (int tt = 0; tt < 17; ++tt)
#pragma unroll
            for (int jj = 0; jj < 4; ++jj) { const int kl = 16 * (kt0 + tt) + 4 * q + jj; const int kpos = 128 * (nb - 1) + kl;
                int dist = 128 + q0 + r - kl; dist = dist < 0 ? -dist : dist;
                const bool valid = dist <= 128 && kpos >= 0 && kpos < SEQ;
                const float lg = valid ? S[tt][jj] - slope * (float)dist : -1e30f;
                S[tt][jj] = lg; mx = fmaxf(mx, lg); }
        mx = fmaxf(mx, __shfl_xor(mx, 16)); mx = fmaxf(mx, __shfl_xor(mx, 32));
        float sum = 0.f;
#pragma unroll
        for (int tt = 0; tt < 17; ++tt)
#pragma unroll
            for (int jj = 0; jj < 4; ++jj) { const float pe = __expf(S[tt][jj] - mx); S[tt][jj] = pe; sum += pe; }
        sum += __shfl_xor(sum, 16); sum += __shfl_xor(sum, 32);
        const float inv = 1.0f / (sum + __expf(snk - mx));
        f32x4 O[4];
#pragma unroll
        for (int dt = 0; dt < 4; ++dt) O[dt] = (f32x4){0.f, 0.f, 0.f, 0.f};
#pragma unroll
        for (int pr = 0; pr < 9; ++pr) {
            const int t0 = 2 * pr, t1 = 2 * pr + 1;
            u32x4 pw; pw.x = pk2(S[t0][0], S[t0][1]); pw.y = pk2(S[t0][2], S[t0][3]);
            if (t1 < 17) { pw.z = pk2(S[t1 < 17 ? t1 : 16][0], S[t1 < 17 ? t1 : 16][1]); pw.w = pk2(S[t1 < 17 ? t1 : 16][2], S[t1 < 17 ? t1 : 16][3]); } else { pw.z = 0u; pw.w = 0u; }
            const bf16x8 Pf = __builtin_bit_cast(bf16x8, pw);
#pragma unroll
            for (int dt = 0; dt < 4; ++dt) {
                const LAS unsigned char* vp = lds + AT_VT + (16 * dt + r) * AT_VT_LD + (16 * (kt0 + t0) + 4 * q) * 2;
                const u32x2 lo = *(const LAS u32x2*)vp; u32x2 hi = (u32x2){0u, 0u};
                if (t1 < 17) hi = *(const LAS u32x2*)(vp + 32);
                const bf16x8 Vf = __builtin_bit_cast(bf16x8, (u32x4){lo.x, lo.y, hi.x, hi.y});
                O[dt] = __builtin_amdgcn_mfma_f32_16x16x32_bf16(Vf, Pf, O[dt], 0, 0, 0);
            }
        }
        bf16_t* dst = YAT + (size_t)(b * SEQ + qpos) * 1024 + h * 64 + 4 * q;
#pragma unroll
        for (int dt = 0; dt < 4; ++dt) *(u32x2*)(dst + 16 * dt) = (u32x2){pk2(O[dt][0] * inv, O[dt][1] * inv), pk2(O[dt][2] * inv, O[dt][3] * inv)};
    }
}

__device__ __forceinline__ void phase_mix(const Params& p, int l, LAS unsigned char* lds) {
    const int G = gridDim.x;
    const bf16_t* PB = (const bf16_t*)(p.ws + WS_PB);
    for (int c = blockIdx.x; c < 512; c += G)
        hyena_conv_unit(lds, (const bf16_t*)(p.ws + WS_KF) + ((size_t)l * 512 + c) * 8192, (const bf16_t*)(p.ws + WS_ZVT) + (size_t)c * 4 * SEQ, (float*)(p.ws + WS_CONVT) + (size_t)c * 4 * SEQ);
    for (int u = blockIdx.x; u < 512; u += G)
        attn_unit(lds, PB, (bf16_t*)(p.ws + WS_YAT), u, p.in[19] + l * 64, p.in[20] + l * 64, p.in[21] + l * 16);
    __syncthreads();
}

constexpr int PO_LD = 516;
__device__ __forceinline__ void ld8(const bf16_t* p, bool ok, float (&f)[8]) {
    u32x4 a = (u32x4){0u, 0u, 0u, 0u}; if (ok) a = *(const u32x4*)p;
    f[0] = bflo(a.x); f[1] = bfhi(a.x); f[2] = bflo(a.y); f[3] = bfhi(a.y); f[4] = bflo(a.z); f[5] = bfhi(a.z); f[6] = bflo(a.w); f[7] = bfhi(a.w);
}
__device__ __forceinline__ void phase_post(const Params& p, int l, LAS unsigned char* lds) {
    LAS float* Cs = (LAS float*)lds;
    const int tid = threadIdx.x, lane = tid & 63, wid = tid >> 6, G = gridDim.x;
    const bf16_t* PB = (const bf16_t*)(p.ws + WS_PB); const float* CONVT = (const float*)(p.ws + WS_CONVT); const bf16_t* YAT = (const bf16_t*)(p.ws + WS_YAT);
    bf16_t* YB = (bf16_t*)(p.ws + WS_HB);
    const float* sw = p.in[7] + l * 3 * 1536; const float* sb = p.in[8] + l * 1536; const float* bd = p.in[17] + l * 512; const float* cw = p.in[18] + l * 3 * 512;
    const int c = lane * 8;
    for (int u = blockIdx.x; u < MTOK / 32; u += G) {
        const int tg0 = u * 32, b = tg0 >> 12, tt = tg0 & 4095;
        __syncthreads();
#pragma unroll
        for (int k = 0; k < 8; ++k) { const int idx = tid + k * NTHREADS; const int cc = idx >> 3, ch = idx & 7;
            const f32x4 v = *(const f32x4*)(CONVT + ((size_t)cc * 4 + b) * SEQ + tt + ch * 4);
#pragma unroll
            for (int e = 0; e < 4; ++e) Cs[(ch * 4 + e) * PO_LD + cc] = v[e]; }
        __syncthreads();
        for (int ti = 0; ti < 4; ++ti) {
            const int tl = wid * 4 + ti, t = tt + tl;
            const bf16_t* row = PB + (size_t)(b * SEQ + t) * NPROJ;
            const bool okm = t > 0, okp = t < SEQ - 1;
            float yv[8];
            {
                float um[3][8];
#pragma unroll
                for (int part = 0; part < 3; ++part) {
                    float pm[8], pc[8], pp[8];
                    ld8(row - NPROJ + part * 512 + c, okm, pm); ld8(row + part * 512 + c, true, pc); ld8(row + NPROJ + part * 512 + c, okp, pp);
#pragma unroll
                    for (int hh = 0; hh < 2; ++hh) { const f32x4 w0 = *(const f32x4*)(sw + part * 512 + c + hh * 4), w1 = *(const f32x4*)(sw + 1536 + part * 512 + c + hh * 4), w2 = *(const f32x4*)(sw + 3072 + part * 512 + c + hh * 4), bb = *(const f32x4*)(sb + part * 512 + c + hh * 4);
#pragma unroll
                        for (int e = 0; e < 4; ++e) um[part][hh * 4 + e] = w0[e] * pm[hh * 4 + e] + w1[e] * pc[hh * 4 + e] + w2[e] * pp[hh * 4 + e] + bb[e]; }
                }
                const f32x4 c0 = *(const LAS f32x4*)(Cs + tl * PO_LD + c), c1 = *(const LAS f32x4*)(Cs + tl * PO_LD + c + 4);
                const f32x4 d0 = *(const f32x4*)(bd + c), d1 = *(const f32x4*)(bd + c + 4);
                float ss = 0.f;
#pragma unroll
                for (int e = 0; e < 8; ++e) { const float zv = um[2][e] * um[1][e]; const float cv = e < 4 ? c0[e] : c1[e - 4]; const float dd = e < 4 ? d0[e] : d1[e - 4];
                    yv[e] = um[0][e] * (cv + zv * dd); ss += yv[e] * yv[e]; }
                ss = wave_sum(ss);
                const float rs = rsqrtf(ss * (1.0f / 512.0f) + EPS);
                *(u32x4*)(YB + (size_t)(b * SEQ + t) * DM + c) = (u32x4){pk2(yv[0] * rs, yv[1] * rs), pk2(yv[2] * rs, yv[3] * rs), pk2(yv[4] * rs, yv[5] * rs), pk2(yv[6] * rs, yv[7] * rs)};
            }
            {
                float gbv[8], cm[8], hm[8], cc0[8], hc[8], cp[8], hp[8];
                ld8(row + 1536 + c, true, gbv);
                ld8(row - NPROJ + 2048 + c, okm, cm); ld8(row - NPROJ + 2560 + c, okm, hm);
                ld8(row + 2048 + c, true, cc0); ld8(row + 2560 + c, true, hc);
                ld8(row + NPROJ + 2048 + c, okp, cp); ld8(row + NPROJ + 2560 + c, okp, hp);
                float ss = 0.f;
#pragma unroll
                for (int hh = 0; hh < 2; ++hh) { const f32x4 w0 = *(const f32x4*)(cw + c + hh * 4), w1 = *(const f32x4*)(cw + 512 + c + hh * 4), w2 = *(const f32x4*)(cw + 1024 + c + hh * 4);
#pragma unroll
                    for (int e = 0; e < 4; ++e) { const int k = hh * 4 + e; const float y = gbv[k] * (w0[e] * cm[k] * hm[k] + w1[e] * cc0[k] * hc[k] + w2[e] * cp[k] * hp[k]); yv[k] = y; ss += y * y; } }
                ss = wave_sum(ss);
                const float rs = rsqrtf(ss * (1.0f / 512.0f) + EPS);
                *(u32x4*)(YB + (size_t)(b * SEQ + t) * DM + 512 + c) = (u32x4){pk2(yv[0] * rs, yv[1] * rs), pk2(yv[2] * rs, yv[3] * rs), pk2(yv[4] * rs, yv[5] * rs), pk2(yv[6] * rs, yv[7] * rs)};
            }
            {
                float a0[8], a1[8];
                const bf16_t* ya = YAT + (size_t)(b * SEQ + t) * 1024;
                ld8(ya + c, true, a0); ld8(ya + 512 + c, true, a1);
                float ss = 0.f;
#pragma unroll
                for (int e = 0; e < 8; ++e) ss += a0[e] * a0[e] + a1[e] * a1[e];
                ss = wave_sum(ss);
                const float rs = rsqrtf(ss * (1.0f / 1024.0f) + EPS);
                bf16_t* yo = YB + (size_t)(b * SEQ + t) * DM + 1024;
                *(u32x4*)(yo + c) = (u32x4){pk2(a0[0] * rs, a0[1] * rs), pk2(a0[2] * rs, a0[3] * rs), pk2(a0[4] * rs, a0[5] * rs), pk2(a0[6] * rs, a0[7] * rs)};
                *(u32x4*)(yo + 512 + c) = (u32x4){pk2(a1[0] * rs, a1[1] * rs), pk2(a1[2] * rs, a1[3] * rs), pk2(a1[4] * rs, a1[5] * rs), pk2(a1[6] * rs, a1[7] * rs)};
            }
        }
    }
    __syncthreads();
}

template <class Epi> __device__ __forceinline__ void run_gemm(LAS unsigned char* lds, const bf16_t* A, const bf16_t* Bt, int N, int K, const Epi& E) {
    pg8::Gemm g{A, Bt, MTOK, N, K}; pg8::StaticOrder S; S.init(MTOK, N, (int)gridDim.x, (int)blockIdx.x);
    pg8::gemm_phase<Epi, pg8::StaticOrder, false>(lds, g, S, E, nullptr);
}

constexpr int N_PHASES = 25;
#define IN(k) (lo <= (k) && (k) < hi)
#define SEAM(k) do { if (IN(k) && IN((k) + 1)) grid.sync(); } while (0)
template <int L> __device__ __forceinline__ void layer_fwd(const Params& p, LAS unsigned char* lds, cg::grid_group& grid, const int lo, const int hi) {
    unsigned char* ws = p.ws;
    bf16_t* HB = (bf16_t*)(ws + WS_HB); bf16_t* ACT = (bf16_t*)(ws + WS_ACT); bf16_t* PB = (bf16_t*)(ws + WS_PB);
    constexpr int P0 = 1 + 12 * L;
    const float* xin = L == 0 ? p.in[0] : p.out;
    if (IN(P0 + 0)) { phase_rmsnorm(xin, HB); } SEAM(P0 + 0);
    if (IN(P0 + 1)) { pg8::EpiGU E{ACT, DFF}; run_gemm(lds, HB, (const bf16_t*)(ws + WS_WGU + (size_t)(L * 2 + 0) * SZ_WGU), 2 * DFF, DM, E); } SEAM(P0 + 1);
    if (IN(P0 + 2)) { pg8::EpiRes E{xin, p.out, DM, 0.5f}; run_gemm(lds, ACT, (const bf16_t*)(ws + WS_WDN + (size_t)(L * 2 + 0) * SZ_WDN), DM, DFF, E); } SEAM(P0 + 2);
    if (IN(P0 + 3)) { phase_rmsnorm(p.out, HB); } SEAM(P0 + 3);
    if (IN(P0 + 4)) { pg8::EpiB16 E{PB, NPROJ}; run_gemm(lds, HB, (const bf16_t*)(ws + WS_WIN + (size_t)L * SZ_WIN), NPROJ, DM, E); } SEAM(P0 + 4);
    if (IN(P0 + 5)) { phase_hyprep(p, L); } SEAM(P0 + 5);
    if (IN(P0 + 6)) { phase_mix(p, L, lds); } SEAM(P0 + 6);
    if (IN(P0 + 7)) { phase_post(p, L, lds); } SEAM(P0 + 7);
    if (IN(P0 + 8)) { pg8::EpiRes E{p.out, p.out, DM, 1.0f}; run_gemm(lds, HB, (const bf16_t*)(ws + WS_WOUT + (size_t)L * SZ_WOUT), DM, DM, E); } SEAM(P0 + 8);
    if (IN(P0 + 9)) { phase_rmsnorm(p.out, HB); } SEAM(P0 + 9);
    if (IN(P0 + 10)) { pg8::EpiGU E{ACT, DFF}; run_gemm(lds, HB, (const bf16_t*)(ws + WS_WGU + (size_t)(L * 2 + 1) * SZ_WGU), 2 * DFF, DM, E); } SEAM(P0 + 10);
    if (IN(P0 + 11)) { pg8::EpiRes E{p.out, p.out, DM, 0.5f}; run_gemm(lds, ACT, (const bf16_t*)(ws + WS_WDN + (size_t)(L * 2 + 1) * SZ_WDN), DM, DFF, E); } SEAM(P0 + 11);
}
__global__ void __launch_bounds__(NTHREADS, 2) mega_fwd(Params p) {
    extern __shared__ __attribute__((aligned(16))) unsigned char shm[];
    LAS unsigned char* lds = (LAS unsigned char*)shm;
    cg::grid_group grid = cg::this_grid();
    const int lo = p.ph_lo, hi = p.ph_hi;
    if (IN(0)) { phase_filter(p, lds); phase_convert(p, lds); } SEAM(0);
    layer_fwd<0>(p, lds, grid, lo, hi);
    layer_fwd<1>(p, lds, grid, lo, hi);
}

extern "C" void kernel_launch(void* const* d_in, const int* in_sizes, int n_in, void* d_out, int out_size, void* d_ws, size_t ws_size, hipStream_t stream) {
    static int grid = 0;
    if (grid == 0) {
        if (n_in != 28 || in_sizes[0] != MTOK * DM || out_size != MTOK * DM || ws_size < WS_END) { fprintf(stderr, "kernel_launch: unexpected shapes / workspace (n_in %d, ws %zu < %zu)\n", n_in, ws_size, (size_t)WS_END); grid = -1; return; }
        int dev = 0, cus = 0, per_cu = 0;
        hipGetDevice(&dev); hipDeviceGetAttribute(&cus, hipDeviceAttributeMultiprocessorCount, dev);
        if (hipFuncSetAttribute((const void*)mega_fwd, hipFuncAttributeMaxDynamicSharedMemorySize, LDS_BYTES) != hipSuccess) { fprintf(stderr, "kernel_launch: hipFuncSetAttribute failed\n"); grid = -1; return; }
        if (hipOccupancyMaxActiveBlocksPerMultiprocessor(&per_cu, (const void*)mega_fwd, NTHREADS, LDS_BYTES) != hipSuccess || per_cu < 1) { fprintf(stderr, "kernel_launch: occupancy query gave %d\n", per_cu); per_cu = 1; }
        (void)hipGetLastError();
        grid = cus * per_cu;
    }
    if (grid < 0) return;
    Params p{};
    for (int i = 0; i < 28; ++i) p.in[i] = (const float*)d_in[i];
    p.out = (float*)d_out; p.ws = (unsigned char*)d_ws;
#if defined(MK_PER_PHASE)
    for (int ph = 0; ph < N_PHASES; ++ph) { p.ph_lo = ph; p.ph_hi = ph + 1; hipLaunchKernelGGL(mega_fwd, dim3(grid), dim3(NTHREADS), LDS_BYTES, stream, p); }
#else
    p.ph_lo = 0; p.ph_hi = N_PHASES;
    void* args[] = {&p};
    hipError_t e = hipLaunchCooperativeKernel((const void*)mega_fwd, dim3(grid), dim3(NTHREADS), args, LDS_BYTES, stream);
    if (e != hipSuccess) fprintf(stderr, "cooperative launch failed: %s (grid %d)\n", hipGetErrorString(e), grid);
#endif
}
```

```cpp
#include <hip/hip_runtime.h>
#include <hip/hip_cooperative_groups.h>
#include <cstdio>
namespace cg = cooperative_groups;
#include <hip/hip_runtime.h>
namespace pg8 {
#define PG8_LAS __attribute__((address_space(3)))
typedef unsigned short bf16_t;
typedef short bf16x8 __attribute__((ext_vector_type(8)));
typedef float f32x4 __attribute__((ext_vector_type(4)));
typedef unsigned u32x4 __attribute__((ext_vector_type(4)));
constexpr int BM = 256, BK = 64, HALF = 128, HTB = HALF * BK * 2  , STAGE_BYTES = 8 * HTB, NXCD = 8, WGM = 8;

__host__ __device__ __forceinline__ int lds_byte(int r, int c) { const int st = (r >> 4) * 2 + (c >> 5), rr = r & 15, cc = c & 31, ob = rr * 64 + cc * 2; return st * 1024 + (ob ^ (((ob >> 9) & 1) << 5)); }
__host__ __device__ __forceinline__ void stage_rc(int b, int& R, int& C) { const int st = b / 1024, sb = b % 1024, swz = sb ^ (((sb >> 9) & 1) << 5); R = (st >> 1) * 16 + swz / 64; C = (st & 1) * 32 + (swz % 64) / 2; }
__host__ __device__ __forceinline__ int perm32(int rho) { const int n = rho >> 4, i = rho & 15; return 8 * (i >> 2) + 4 * n + (i & 3); }

struct Unit { int pm, pn; };
struct Gemm { const bf16_t* A; const bf16_t* Bt; int M, N, K; };

struct StaticOrder {
    int nM, nN, nwg, G, c;
    __host__ __device__ void init(int M, int N, int G_, int c_) { nM = M / BM; nN = N / BM; nwg = nM * nN; G = G_; c = c_; }
    __host__ __device__ bool next(int i, Unit& u) const {
        const long L = (long)i * G + c; if (L >= nwg) return false;
        int wgid = (int)L; { const int q = nwg / NXCD, r = nwg % NXCD, xcd = wgid % NXCD, off = wgid / NXCD; wgid = (xcd < r ? xcd * (q + 1) : r * (q + 1) + (xcd - r) * q) + off; }
        const int nig = WGM * nN, gid = wgid / nig, fm = gid * WGM, gsz = (nM - fm) < WGM ? (nM - fm) : WGM;
        u.pm = fm + ((wgid % nig) % gsz); u.pn = (wgid % nig) / gsz; return true;
    }
    __device__ __forceinline__ void a_ready(const Unit&) const {}
    __device__ __forceinline__ void done(const Unit&) const {}
};
__device__ __forceinline__ unsigned cvt_pk_bf16(float lo, float hi) { unsigned r; asm volatile("v_cvt_pk_bf16_f32 %0, %1, %2" : "=v"(r) : "v"(lo), "v"(hi)); return r; }

__device__ __forceinline__ void row_rstd(const unsigned long long* ss, int row0, float (&rs)[2][4]) {
#pragma unroll
    for (int ai = 0; ai < 2; ++ai)
#pragma unroll
        for (int m = 0; m < 4; ++m) rs[ai][m] = ss ? __builtin_amdgcn_rsqf((float)ss[row0 + ai * HALF + m * 16] * (1.0f / (2048.0f * 1048576.0f)) + 1e-6f) : 1.0f;
}
struct EpiB16 {
    static constexpr bool PERM = true, AFTER_DRAIN = false;
    bf16_t* O; int ldc; const unsigned long long* ss;
    __device__ __forceinline__ void operator()(const f32x4 (&acc)[2][2][4][2], const Unit& u, int wr, int wc, int fr, int fq) const {
        const int row0 = u.pm * BM + wr * 64 + fr, col0 = u.pn * BM + wc * 32 + 8 * fq;
        float rs[2][4]; row_rstd(ss, row0, rs);
#pragma unroll
        for (int ai = 0; ai < 2; ++ai)
#pragma unroll
            for (int m = 0; m < 4; ++m) { bf16_t* rowp = O + (size_t)(row0 + ai * HALF + m * 16) * ldc + col0;
#pragma unroll
                for (int bj = 0; bj < 2; ++bj) { const f32x4 v0 = acc[ai][bj][m][0] * rs[ai][m], v1 = acc[ai][bj][m][1] * rs[ai][m];
                    u32x4 w; w.x = cvt_pk_bf16(v0[0], v0[1]); w.y = cvt_pk_bf16(v0[2], v0[3]); w.z = cvt_pk_bf16(v1[0], v1[1]); w.w = cvt_pk_bf16(v1[2], v1[3]);
                    __builtin_nontemporal_store(w, (u32x4*)(rowp + bj * HALF)); } }
    }
};
__device__ __forceinline__ float silu_mul(float g, float u) { return g * u * __builtin_amdgcn_rcpf(1.0f + __builtin_amdgcn_exp2f(-1.44269504089f * g)); }
struct EpiGU {
    static constexpr bool PERM = true, AFTER_DRAIN = false;
    bf16_t* O; int ldc; const unsigned long long* ss;
    __device__ __forceinline__ void operator()(const f32x4 (&acc)[2][2][4][2], const Unit& u, int wr, int wc, int fr, int fq) const {
        const int row0 = u.pm * BM + wr * 64 + fr, col0 = u.pn * HALF + wc * 32 + 8 * fq;
        float rs[2][4]; row_rstd(ss, row0, rs);
#pragma unroll
        for (int ai = 0; ai < 2; ++ai)
#pragma unroll
            for (int m = 0; m < 4; ++m) { bf16_t* rowp = O + (size_t)(row0 + ai * HALF + m * 16) * ldc + col0;
                const f32x4 g0 = acc[ai][0][m][0] * rs[ai][m], g1 = acc[ai][0][m][1] * rs[ai][m], u0 = acc[ai][1][m][0] * rs[ai][m], u1 = acc[ai][1][m][1] * rs[ai][m];
                u32x4 w;
                w.x = cvt_pk_bf16(silu_mul(g0[0], u0[0]), silu_mul(g0[1], u0[1])); w.y = cvt_pk_bf16(silu_mul(g0[2], u0[2]), silu_mul(g0[3], u0[3]));
                w.z = cvt_pk_bf16(silu_mul(g1[0], u1[0]), silu_mul(g1[1], u1[1])); w.w = cvt_pk_bf16(silu_mul(g1[2], u1[2]), silu_mul(g1[3], u1[3]));
                __builtin_nontemporal_store(w, (u32x4*)rowp); }
    }
};
struct EpiResB {
    static constexpr bool PERM = true, AFTER_DRAIN = false;
    bf16_t* XB; float* OUT; int ldc; float scale; unsigned long long* ss_out;
    __device__ __forceinline__ void operator()(const f32x4 (&acc)[2][2][4][2], const Unit& u, int wr, int wc, int fr, int fq) const {
        const int row0 = u.pm * BM + wr * 64 + fr, col0 = u.pn * BM + wc * 32 + 8 * fq;
#pragma unroll
        for (int ai = 0; ai < 2; ++ai) {
            u32x4 xo[4][2];
#pragma unroll
            for (int m = 0; m < 4; ++m)
#pragma unroll
                for (int bj = 0; bj < 2; ++bj) xo[m][bj] = *(const u32x4*)(XB + (size_t)(row0 + ai * HALF + m * 16) * ldc + col0 + bj * HALF);
#pragma unroll
            for (int m = 0; m < 4; ++m) { const size_t off = (size_t)(row0 + ai * HALF + m * 16) * ldc + col0; float sq = 0.f;
#pragma unroll
                for (int bj = 0; bj < 2; ++bj) { const u32x4 x = xo[m][bj];
                    const f32x4 v0 = (f32x4){__uint_as_float(x.x << 16), __uint_as_float(x.x & 0xffff0000u), __uint_as_float(x.y << 16), __uint_as_float(x.y & 0xffff0000u)} + acc[ai][bj][m][0] * scale;
                    const f32x4 v1 = (f32x4){__uint_as_float(x.z << 16), __uint_as_float(x.z & 0xffff0000u), __uint_as_float(x.w << 16), __uint_as_float(x.w & 0xffff0000u)} + acc[ai][bj][m][1] * scale;
                    sq += v0[0] * v0[0] + v0[1] * v0[1] + v0[2] * v0[2] + v0[3] * v0[3] + v1[0] * v1[0] + v1[1] * v1[1] + v1[2] * v1[2] + v1[3] * v1[3];
                    if (OUT) { __builtin_nontemporal_store(v0, (f32x4*)(OUT + off + bj * HALF)); __builtin_nontemporal_store(v1, (f32x4*)(OUT + off + bj * HALF + 4)); }
                    else { u32x4 w; w.x = cvt_pk_bf16(v0[0], v0[1]); w.y = cvt_pk_bf16(v0[2], v0[3]); w.z = cvt_pk_bf16(v1[0], v1[1]); w.w = cvt_pk_bf16(v1[2], v1[3]); __builtin_nontemporal_store(w, (u32x4*)(XB + off + bj * HALF)); } }
                if (ss_out) { sq += __shfl_xor(sq, 16); sq += __shfl_xor(sq, 32); if (fq == 0) atomicAdd(ss_out + row0 + ai * HALF + m * 16, (unsigned long long)(sq * 1048576.0f)); } }
        }
    }
};

template <class Epi, class Sched, bool STAMP = false>
__device__ __forceinline__ void gemm_phase(PG8_LAS unsigned char* lds, const Gemm g, const Sched& S, const Epi& E, unsigned long long* stamps) {
    const int tid = threadIdx.x, wid = __builtin_amdgcn_readfirstlane(tid >> 6), lane = tid & 63, wr = wid >> 2, wc = wid & 3, fr = lane & 15, fq = lane >> 4;
    const int K = g.K, nt = K / BK;
    int ts_lo = 0, ts_hi = 0, nts = 0; const unsigned long long rt_entry = STAMP ? (unsigned long long)wall_clock64() : 0ull;
#define PG8_STAMP() do { if (STAMP && wid == 0 && nts < 64) { const unsigned long long _c = (unsigned long long)clock64(); \
        ts_lo = (lane == nts) ? (int)(unsigned)_c : ts_lo; ts_hi = (lane == nts) ? (int)(unsigned)(_c >> 32) : ts_hi; ++nts; } } while (0)
    PG8_STAMP();
    unsigned voffA[2], voffB[2];
#pragma unroll
    for (int i = 0; i < 2; ++i) { int R, C; stage_rc(tid * 16 + i * 8192, R, C); const int Rb = Epi::PERM ? ((R & ~31) + perm32(R & 31)) : R;
        voffA[i] = (unsigned)(R * K + C) * 2u; voffB[i] = (unsigned)(Rb * K + C) * 2u; }
    const size_t kstep = (size_t)(BK * 2);
    const size_t hstep = (size_t)HALF * K * 2;
    const size_t tstep = 2 * hstep;
    const unsigned ldsw = (unsigned)wid * 1024u;
    const int aoff = lds_byte(wr * 64 + fr, fq * 8), boff = lds_byte(wc * 32 + fr, fq * 8);
#define PG8_SA(b, h) (((b) * 2 + (h)) * HTB)
#define PG8_SB(b, h) ((4 + (b) * 2 + (h)) * HTB)
#define PG8_STAGE(bufoff, gbase, voff) do { _Pragma("unroll") for (int _i = 0; _i < 2; ++_i) \
        __builtin_amdgcn_global_load_lds((const unsigned*)((const char*)(gbase) + (voff)[_i]), (PG8_LAS unsigned*)(lds + (bufoff) + ldsw + _i * 8192), 16, 0, 0); } while (0)
#define PG8_LDA(dst, b, h) do { _Pragma("unroll") for (int m = 0; m < 4; ++m) _Pragma("unroll") for (int k = 0; k < 2; ++k) dst[m][k] = *(const PG8_LAS bf16x8*)(lds + PG8_SA(b, h) + aoff + m * 2048 + k * 1024); } while (0)
#define PG8_LDB(dst, b, h) do { _Pragma("unroll") for (int n = 0; n < 2; ++n) _Pragma("unroll") for (int k = 0; k < 2; ++k) dst[n][k] = *(const PG8_LAS bf16x8*)(lds + PG8_SB(b, h) + boff + n * 2048 + k * 1024); } while (0)
#define PG8_MMA(ai, bj, At, Bt) do { __builtin_amdgcn_s_setprio(1); _Pragma("unroll") for (int m = 0; m < 4; ++m) _Pragma("unroll") for (int n = 0; n < 2; ++n) _Pragma("unroll") for (int k = 0; k < 2; ++k) \
        acc[ai][bj][m][n] = __builtin_amdgcn_mfma_f32_16x16x32_bf16(Bt[n][k], At[m][k], acc[ai][bj][m][n], 0, 0, 0); __builtin_amdgcn_s_setprio(0); } while (0)
#define PG8_WAIT_V(n) asm volatile("s_waitcnt vmcnt(" #n ")" ::: "memory")
#define PG8_WAIT_L(n) asm volatile("s_waitcnt lgkmcnt(" #n ")" ::: "memory")
#define PG8_BAR __builtin_amdgcn_s_barrier()
#define PG8_SCHED __builtin_amdgcn_sched_barrier(0)
    Unit cur, nxt; int ui = 0;
    if (!S.next(0, cur)) return;
    f32x4 acc[2][2][4][2];
#pragma unroll
    for (int a = 0; a < 2; ++a)
#pragma unroll
        for (int b = 0; b < 2; ++b)
#pragma unroll
            for (int m = 0; m < 4; ++m)
#pragma unroll
                for (int n = 0; n < 2; ++n) acc[a][b][m][n] = (f32x4){0.f, 0.f, 0.f, 0.f};
    bf16x8 At[4][2], B0[2][2], B1[2][2];
    const char* cA = (const char*)g.A + (size_t)cur.pm * tstep; const char* cB = (const char*)g.Bt + (size_t)cur.pn * tstep;
    S.a_ready(cur);
    PG8_STAGE(PG8_SB(0, 0), cB, voffB); PG8_STAGE(PG8_SA(0, 0), cA, voffA); PG8_STAGE(PG8_SB(0, 1), cB + hstep, voffB); PG8_STAGE(PG8_SA(0, 1), cA + hstep, voffA);
    if (wr == 1) PG8_BAR;
    PG8_WAIT_V(4); PG8_BAR;
    PG8_STAGE(PG8_SB(1, 0), cB + kstep, voffB); PG8_STAGE(PG8_SA(1, 0), cA + kstep, voffA); PG8_STAGE(PG8_SB(1, 1), cB + hstep + kstep, voffB);
    PG8_WAIT_V(6); PG8_BAR;
    PG8_STAMP();
    for (;;) {
        const bool has_next = S.next(ui + 1, nxt);
        const char* nA = has_next ? (const char*)g.A + (size_t)nxt.pm * tstep : cA; const char* nB = has_next ? (const char*)g.Bt + (size_t)nxt.pn * tstep : cB;
        for (int t = 0; t < nt; t += 2) {
            const bool last = (t == nt - 2);
            const char* a1 = cA + (size_t)(t + 1) * kstep;
            const char* a2 = last ? nA : cA + (size_t)(t + 2) * kstep; const char* b2 = last ? nB : cB + (size_t)(t + 2) * kstep;
            const char* a3 = a2 + kstep; const char* b3 = b2 + kstep;
            if (last && has_next) S.a_ready(nxt);
            PG8_LDB(B0, 0, 0); PG8_SCHED; PG8_LDA(At, 0, 0); PG8_STAGE(PG8_SA(1, 1), a1 + hstep, voffA);
            PG8_WAIT_L(8); PG8_BAR; PG8_WAIT_L(0); PG8_MMA(0, 0, At, B0); PG8_BAR; PG8_SCHED;
            PG8_LDB(B1, 0, 1); PG8_STAGE(PG8_SB(0, 0), b2, voffB);
            PG8_BAR; PG8_WAIT_L(0); PG8_MMA(0, 1, At, B1); PG8_BAR;
            PG8_LDA(At, 0, 1); PG8_STAGE(PG8_SA(0, 0), a2, voffA);
            PG8_BAR; PG8_WAIT_L(0); PG8_MMA(1, 0, At, B0); PG8_BAR; PG8_SCHED;
            PG8_STAGE(PG8_SB(0, 1), b2 + hstep, voffB);
            PG8_WAIT_V(6); PG8_BAR; PG8_MMA(1, 1, At, B1); PG8_BAR;
            PG8_LDB(B0, 1, 0); PG8_SCHED; PG8_LDA(At, 1, 0); PG8_STAGE(PG8_SA(0, 1), a2 + hstep, voffA);
            PG8_WAIT_L(8); PG8_BAR; PG8_WAIT_L(0); PG8_MMA(0, 0, At, B0); PG8_BAR; PG8_SCHED;
            PG8_LDB(B1, 1, 1); PG8_STAGE(PG8_SB(1, 0), b3, voffB);
            PG8_BAR; PG8_WAIT_L(0); PG8_MMA(0, 1, At, B1); PG8_BAR;
            PG8_LDA(At, 1, 1); PG8_STAGE(PG8_SA(1, 0), a3, voffA);
            PG8_BAR; PG8_WAIT_L(0); PG8_MMA(1, 0, At, B0); PG8_BAR; PG8_SCHED;
            PG8_STAGE(PG8_SB(1, 1), b3 + hstep, voffB);
            PG8_WAIT_V(6); PG8_BAR; PG8_MMA(1, 1, At, B1); PG8_BAR;
        }
        PG8_STAMP();
        if constexpr (!Epi::AFTER_DRAIN) { E(acc, cur, wr, wc, fr, fq); S.done(cur); }
        PG8_STAMP();
        if (!has_next) break;
#pragma unroll
        for (int a = 0; a < 2; ++a)
#pragma unroll
            for (int b = 0; b < 2; ++b)
#pragma unroll
                for (int m = 0; m < 4; ++m)
#pragma unroll
                    for (int n = 0; n < 2; ++n) acc[a][b][m][n] = (f32x4){0.f, 0.f, 0.f, 0.f};
        cur = nxt; cA = nA; cB = nB; ++ui;
    }
    PG8_WAIT_V(0);
    if (wr == 0) PG8_BAR;
    PG8_BAR;
    if constexpr (Epi::AFTER_DRAIN) { E.fused(acc, cur, wr, wc, fr, fq, lds, wid, lane); S.done(cur); }
    PG8_STAMP();
    if (STAMP && wid == 0) { stamps[lane] = lane < nts ? (((unsigned long long)(unsigned)ts_hi << 32) | (unsigned)ts_lo) : 0ull;
        if (lane == 62) stamps[62] = rt_entry; if (lane == 63) stamps[63] = (unsigned long long)wall_clock64(); }
#undef PG8_STAMP
#undef PG8_SA
#undef PG8_SB
#undef PG8_STAGE
#undef PG8_LDA
#undef PG8_LDB
#undef PG8_MMA
#undef PG8_WAIT_V
#undef PG8_WAIT_L
#undef PG8_BAR
#undef PG8_SCHED
}
}

#define LAS __attribute__((address_space(3)))
typedef unsigned short bf16_t;
typedef short bf16x8 __attribute__((ext_vector_type(8)));
typedef float f32x4 __attribute__((ext_vector_type(4)));
typedef unsigned u32x4 __attribute__((ext_vector_type(4)));
typedef unsigned u32x2 __attribute__((ext_vector_type(2)));

constexpr int MTOK = 16384, DM = 2048, DFF = 5632, NPROJ = 4608, SEQ = 4096, NB = 4;
constexpr int NTHREADS = 512;
constexpr int BAR_LDS_OFF = 131072;
constexpr int LDS_BYTES = 131072 + 256;
constexpr float EPS = 1e-6f;

constexpr size_t SZ_WGU = (size_t)2 * DFF * DM * 2, SZ_WDN = (size_t)DM * DFF * 2, SZ_WIN = (size_t)NPROJ * DM * 2, SZ_WOUT = (size_t)DM * DM * 2;
constexpr size_t WS_WGU = 0;
constexpr size_t WS_WDN = WS_WGU + 4 * SZ_WGU;
constexpr size_t WS_WIN = WS_WDN + 4 * SZ_WDN;
constexpr size_t WS_WOUT = WS_WIN + 2 * SZ_WIN;
constexpr size_t WS_KF = WS_WOUT + 2 * SZ_WOUT;
constexpr size_t WS_HB = WS_KF + (size_t)2 * 512 * 8192 * 2;
constexpr size_t WS_UN = WS_HB + (size_t)MTOK * DM * 2;
constexpr size_t WS_ACT = WS_UN;
constexpr size_t WS_PB = WS_UN;
constexpr size_t WS_ZVT = WS_PB + (size_t)MTOK * NPROJ * 2;
constexpr size_t WS_CONVT = WS_ZVT + (size_t)512 * 4 * 4096 * 2;
constexpr size_t WS_YAT = WS_CONVT + (size_t)512 * 4 * 4096 * 4;
constexpr size_t WS_YB = WS_YAT + (size_t)MTOK * 1024 * 2;
constexpr size_t WS_SS = WS_YB + (size_t)MTOK * DM * 2;
constexpr size_t WS_BAR = WS_SS + (size_t)6 * MTOK * 8;
constexpr size_t WS_END = WS_BAR + 16384;
static_assert(WS_END - WS_UN >= (size_t)MTOK * DFF * 2, "union region must hold ACT");

struct Params { const float* in[28]; float* out; unsigned char* ws; int ph_lo, ph_hi; };

__device__ __forceinline__ float bf2f(unsigned short b) { return __uint_as_float(((unsigned)b) << 16); }
__device__ __forceinline__ float bflo(unsigned w) { return __uint_as_float(w << 16); }
__device__ __forceinline__ float bfhi(unsigned w) { return __uint_as_float(w & 0xffff0000u); }
__device__ __forceinline__ unsigned pk2(float lo, float hi) { return pg8::cvt_pk_bf16(lo, hi); }
__device__ __forceinline__ float wave_sum(float v) {
#pragma unroll
    for (int o = 32; o >= 1; o >>= 1) v += __shfl_xor(v, o);
    return v;
}

constexpr int CV_TK = 64, CV_TN = 256, CV_LD = 260;
struct CvJob { const float* src; const float* gain; bf16_t* dst; int K, N, mode; };
constexpr int CV_T_GU = (DM / CV_TK) * (DFF / CV_TN), CV_T_DN = (DFF / CV_TK) * (DM / CV_TN), CV_T_IN = (DM / CV_TK) * (NPROJ / CV_TN), CV_T_OUT = (DM / CV_TK) * (DM / CV_TN);
constexpr int CV_PER_LAYER = 4 * CV_T_GU + 2 * CV_T_DN + CV_T_IN + CV_T_OUT;
__device__ __forceinline__ void cv_decode(const Params& p, int gt, CvJob& j, int& tk, int& tn) {
    const int l = gt / CV_PER_LAYER; int r = gt - l * CV_PER_LAYER;
    unsigned char* ws = p.ws;
    int tiles_n;
    if (r < 4 * CV_T_GU) { const int w = r / CV_T_GU; r -= w * CV_T_GU; const int f = w >> 1, up = w & 1;
        j.src = p.in[(f ? 25 : 2) + up] + (size_t)l * DM * DFF; j.gain = p.in[f ? 24 : 1] + l * DM; j.dst = (bf16_t*)(ws + WS_WGU + (size_t)(l * 2 + f) * SZ_WGU); j.K = DM; j.N = DFF; j.mode = 1 + up; tiles_n = DFF / CV_TN; }
    else if ((r -= 4 * CV_T_GU) < 2 * CV_T_DN) { const int f = r / CV_T_DN; r -= f * CV_T_DN;
        j.src = p.in[f ? 27 : 4] + (size_t)l * DFF * DM; j.gain = nullptr; j.dst = (bf16_t*)(ws + WS_WDN + (size_t)(l * 2 + f) * SZ_WDN); j.K = DFF; j.N = DM; j.mode = 0; tiles_n = DM / CV_TN; }
    else if ((r -= 2 * CV_T_DN) < CV_T_IN) {
        j.src = p.in[6] + (size_t)l * DM * NPROJ; j.gain = p.in[5] + l * DM; j.dst = (bf16_t*)(ws + WS_WIN + (size_t)l * SZ_WIN); j.K = DM; j.N = NPROJ; j.mode = 0; tiles_n = NPROJ / CV_TN; }
    else { r -= CV_T_IN;
        j.src = p.in[23] + (size_t)l * DM * DM; j.gain = p.in[22] + l * DM; j.dst = (bf16_t*)(ws + WS_WOUT + (size_t)l * SZ_WOUT); j.K = DM; j.N = DM; j.mode = 0; tiles_n = DM / CV_TN; }
    tk = r / tiles_n; tn = r - tk * tiles_n;
}
__device__ __forceinline__ void cv_load(const Params& p, int gt, f32x4 (&v)[8]) {
    CvJob j; int tk, tn; cv_decode(p, gt, j, tk, tn);
    const int tid = threadIdx.x;
#pragma unroll
    for (int it = 0; it < 8; ++it) { const int idx = tid + it * NTHREADS, k = idx >> 6, n4 = idx & 63;
        f32x4 x = __builtin_nontemporal_load((const f32x4*)(j.src + (size_t)(tk * CV_TK + k) * j.N + tn * CV_TN + n4 * 4));
        if (j.gain) x = x * j.gain[tk * CV_TK + k];
        v[it] = x; }
}
__device__ __forceinline__ void phase_convert(const Params& p, LAS unsigned char* lds) {
    LAS float* T = (LAS float*)lds;
    const int tid = threadIdx.x, G = gridDim.x;
    const int total = 2 * CV_PER_LAYER;
    int gt = blockIdx.x;
    f32x4 v[8];
    if (gt < total) cv_load(p, gt, v);
    for (; gt < total; gt += G) {
        __syncthreads();
#pragma unroll
        for (int it = 0; it < 8; ++it) { const int idx = tid + it * NTHREADS, k = idx >> 6, n4 = idx & 63; *(LAS f32x4*)(T + k * CV_LD + n4 * 4) = v[it]; }
        CvJob j; int tk, tn; cv_decode(p, gt, j, tk, tn);
        if (gt + G < total) cv_load(p, gt + G, v);
        __syncthreads();
        const int n = tid >> 1, kc = tid & 1;
        unsigned w[16];
#pragma unroll
        for (int i = 0; i < 16; ++i) w[i] = pk2(T[(kc * 32 + 2 * i) * CV_LD + n], T[(kc * 32 + 2 * i + 1) * CV_LD + n]);
        const int ng = tn * CV_TN + n;
        const int row = j.mode == 0 ? ng : ((ng >> 7) * 256 + (j.mode == 2 ? 128 : 0) + (ng & 127));
        bf16_t* d = j.dst + (size_t)row * j.K + tk * CV_TK + kc * 32;
#pragma unroll
        for (int i = 0; i < 4; ++i) *(u32x4*)(d + 8 * i) = (u32x4){w[4 * i], w[4 * i + 1], w[4 * i + 2], w[4 * i + 3]};
    }
    __syncthreads();
}

__device__ __forceinline__ void phase_filter(const Params& p, LAS unsigned char* lds) {
    LAS float* zs = (LAS float*)lds;
    LAS float* h1 = zs + 16 * 33;
    LAS float* h2 = h1 + 16 * 64;
    LAS float* h3 = h2 + 16 * 64;
    const int tid = threadIdx.x, G = gridDim.x;
    bf16_t* KF = (bf16_t*)(p.ws + WS_KF);
    for (int u = blockIdx.x; u < 512; u += G) {
        const int l = u >> 8, n0 = (u & 255) * 16;
        const float* w1 = p.in[9] + l * 33 * 64; const float* b1 = p.in[10] + l * 64;
        const float* w2 = p.in[11] + l * 64 * 64; const float* b2 = p.in[12] + l * 64;
        const float* w3 = p.in[13] + l * 64 * 64; const float* b3 = p.in[14] + l * 64;
        const float* fr = p.in[15] + l * 64; const float* wo = p.in[16] + (size_t)l * 64 * 1024;
        __syncthreads();
        for (int idx = tid; idx < 16 * 33; idx += NTHREADS) { const int pp = idx / 33, e = idx - pp * 33; const float n = (float)(n0 + pp);
            float val;
            if (e == 0) val = n / 4095.0f;
            else { const int k = (e - 1) & 15; const float band = 1e-4f + (float)k * ((15.0f - 1e-4f) / 15.0f); const float ang = (6.283185307179586f / 4096.0f) * n * band;
                val = (e <= 16) ? cosf(ang) : sinf(ang); }
            zs[idx] = val; }
        __syncthreads();
        for (int idx = tid; idx < 16 * 64; idx += NTHREADS) { const int pp = idx >> 6, j = idx & 63; float a = b1[j];
            for (int e = 0; e < 33; ++e) a += zs[pp * 33 + e] * w1[e * 64 + j];
            h1[idx] = sinf(fr[j] * a); }
        __syncthreads();
        for (int idx = tid; idx < 16 * 64; idx += NTHREADS) { const int pp = idx >> 6, j = idx & 63; float a = b2[j];
            for (int e = 0; e < 64; ++e) a += h1[pp * 64 + e] * w2[e * 64 + j];
            h2[idx] = sinf(fr[j] * a); }
        __syncthreads();
        for (int idx = tid; idx < 16 * 64; idx += NTHREADS) { const int pp = idx >> 6, j = idx & 63; float a = b3[j];
            for (int e = 0; e < 64; ++e) a += h2[pp * 64 + e] * w3[e * 64 + j];
            h3[idx] = sinf(fr[j] * a); }
        __syncthreads();
        for (int oo = 0; oo < 2; ++oo) { const int o = tid + oo * NTHREADS; const int c = o & 511;
            float a[16];
#pragma unroll
            for (int pp = 0; pp < 16; ++pp) a[pp] = 0.f;
            for (int k = 0; k < 64; ++k) { const float w = wo[k * 1024 + o];
#pragma unroll
                for (int pp = 0; pp < 16; ++pp) a[pp] += h3[pp * 64 + k] * w; }
            const float dlo = -3.0701134573253945f, dhi = -15.350567286626973f;
            const float delta = fabsf(dlo + (float)c * ((dhi - dlo) / 511.0f));
            bf16_t* kc = KF + ((size_t)l * 512 + c) * 8192;
#pragma unroll
            for (int pp = 0; pp < 16; ++pp) { const float t = (float)(n0 + pp) / 4095.0f; a[pp] *= (expf(-t * delta) + 0.05f); }
            if (oo == 0) {
                unsigned w[8];
#pragma unroll
                for (int i = 0; i < 8; ++i) w[i] = pk2(a[2 * i], a[2 * i + 1]);
                *(u32x4*)(kc + 4096 + n0) = (u32x4){w[0], w[1], w[2], w[3]};
                *(u32x4*)(kc + 4096 + n0 + 8) = (u32x4){w[4], w[5], w[6], w[7]};
                if (n0 == 0) kc[0] = 0;
            } else {
#pragma unroll
                for (int pp = 0; pp < 16; ++pp) { const int n = n0 + pp; if (n >= 1) kc[4096 - n] = (bf16_t)(pk2(a[pp], 0.f) & 0xffffu); }
            }
        }
    }
    __syncthreads();
}

__device__ __forceinline__ void phase_x0(const float* x, bf16_t* xb, unsigned long long* ss) {
    const int lane = threadIdx.x & 63, wave = threadIdx.x >> 6;
    const int gw = blockIdx.x * 8 + wave, nw = gridDim.x * 8;
    for (int i = blockIdx.x * NTHREADS + threadIdx.x; i < 5 * MTOK; i += gridDim.x * NTHREADS) ss[MTOK + i] = 0ull;
    for (int row = gw; row < MTOK; row += nw) {
        const float* xr = x + (size_t)row * DM;
        f32x4 v[8]; float sq = 0.f;
#pragma unroll
        for (int i = 0; i < 8; ++i) v[i] = __builtin_nontemporal_load((const f32x4*)(xr + i * 256 + lane * 4));
#pragma unroll
        for (int i = 0; i < 8; ++i) sq += v[i][0] * v[i][0] + v[i][1] * v[i][1] + v[i][2] * v[i][2] + v[i][3] * v[i][3];
        sq = wave_sum(sq);
        if (lane == 0) ss[row] = (unsigned long long)(sq * 1048576.0f);
        bf16_t* hr = xb + (size_t)row * DM;
#pragma unroll
        for (int i = 0; i < 8; ++i) *(u32x2*)(hr + i * 256 + lane * 4) = (u32x2){pk2(v[i][0], v[i][1]), pk2(v[i][2], v[i][3])};
    }
}

__device__ __forceinline__ void phase_hyprep(const Params& p, int l) {
    const bf16_t* PB = (const bf16_t*)(p.ws + WS_PB); bf16_t* ZVT = (bf16_t*)(p.ws + WS_ZVT);
    const float* sw = p.in[7] + l * 3 * 1536; const float* sb = p.in[8] + l * 1536;
    const int lane = threadIdx.x & 63, wave = threadIdx.x >> 6;
    const int gw = blockIdx.x * 8 + wave, nw = gridDim.x * 8;
    for (int task = gw; task < 4096; task += nw) {
        const int tg = task >> 1, ch = task & 1; const int c = ch * 256 + lane * 4;
        const int tglob = tg * 8, b = tglob >> 12, t0 = tglob & 4095;
        f32x4 w1[3], wv[3];
#pragma unroll
        for (int j = 0; j < 3; ++j) { w1[j] = *(const f32x4*)(sw + j * 1536 + 512 + c); wv[j] = *(const f32x4*)(sw + j * 1536 + 1024 + c); }
        const f32x4 bb1 = *(const f32x4*)(sb + 512 + c), bbv = *(const f32x4*)(sb + 1024 + c);
        f32x4 r1[10], rv[10];
#pragma unroll
        for (int i = 0; i < 10; ++i) { const int t = t0 - 1 + i;
            if (t >= 0 && t < SEQ) { const bf16_t* row = PB + (size_t)(b * SEQ + t) * NPROJ;
                const u32x2 a = *(const u32x2*)(row + 512 + c), d = *(const u32x2*)(row + 1024 + c);
                r1[i] = (f32x4){bflo(a.x), bfhi(a.x), bflo(a.y), bfhi(a.y)}; rv[i] = (f32x4){bflo(d.x), bfhi(d.x), bflo(d.y), bfhi(d.y)}; }
            else { r1[i] = (f32x4){0.f, 0.f, 0.f, 0.f}; rv[i] = r1[i]; } }
        f32x4 zv[8];
#pragma unroll
        for (int i = 0; i < 8; ++i) { const f32x4 x1 = w1[0] * r1[i] + w1[1] * r1[i + 1] + w1[2] * r1[i + 2] + bb1; const f32x4 vv = wv[0] * rv[i] + wv[1] * rv[i + 1] + wv[2] * rv[i + 2] + bbv; zv[i] = x1 * vv; }
#pragma unroll
        for (int e = 0; e < 4; ++e) { const u32x4 w = (u32x4){pk2(zv[0][e], zv[1][e]), pk2(zv[2][e], zv[3][e]), pk2(zv[4][e], zv[5][e]), pk2(zv[6][e], zv[7][e])};
            __builtin_nontemporal_store(w, (u32x4*)(ZVT + ((size_t)(c + e) * 4 + b) * SEQ + t0)); }
    }
}

constexpr int HY_VS = 0, HY_ZS = 66560, HY_TMP = HY_ZS + 4 * 64 * 144;
__device__ __forceinline__ void hyena_conv_unit(LAS unsigned char* lds, const bf16_t* KFc, const bf16_t* ZVc, float* CONVc) {
    const int tid = threadIdx.x, lane = tid & 63, wid = tid >> 6, r = lane & 15, q = lane >> 4;
    const int b = wid >> 1, ib = (wid & 1) * 32;
    __syncthreads();
#pragma unroll
    for (int k = 0; k < 4; ++k) { const int idx = tid + k * NTHREADS; const int bb = idx >> 9, ch = idx & 511;
        const u32x4 v = *(const u32x4*)(ZVc + bb * SEQ + ch * 8);
        *(LAS u32x4*)(lds + HY_ZS + bb * 9216 + (ch >> 3) * 144 + (ch & 7) * 16) = v; }
    f32x4 acc[4][2];
#pragma unroll
    for (int m = 0; m < 4; ++m) { acc[m][0] = (f32x4){0.f, 0.f, 0.f, 0.f}; acc[m][1] = acc[m][0]; }
    LAS unsigned short* TMP = (LAS unsigned short*)(lds + HY_TMP);
    for (int hf = 0; hf < 2; ++hf) {
        const int xlo = hf ? -56 : -4088, cnt = hf ? 4152 : 4088;
        __syncthreads();
        for (int e = tid; e < cnt + 7; e += NTHREADS) TMP[e] = KFc[4096 + xlo - 7 + e];
        __syncthreads();
        for (int e = tid; e < cnt; e += NTHREADS) {
            unsigned w[4];
#pragma unroll
            for (int i = 0; i < 4; ++i) w[i] = (unsigned)TMP[e + 7 - 2 * i] | ((unsigned)TMP[e + 6 - 2 * i] << 16);
            *(LAS u32x4*)(lds + HY_VS + e * 16) = (u32x4){w[0], w[1], w[2], w[3]}; }
        __syncthreads();
        const int dlo = hf ? 0 : -63, dhi = hf ? 63 : -1;
        for (int d = dlo; d <= dhi; ++d) {
            if (ib + 31 - d < 0 || ib - d > 63) continue;
            const int base = 64 * d + r - 8 * q - xlo;
            bf16x8 Af[6];
#pragma unroll
            for (int bi = 0; bi < 6; ++bi) Af[bi] = *(const LAS bf16x8*)(lds + HY_VS + (base - 32 + 16 * bi) * 16);
#pragma unroll
            for (int nt = 0; nt < 2; ++nt) {
                const int i0 = ib + 16 * nt;
                if (i0 + 15 - d < 0 || i0 - d > 63) continue;
                const int j = i0 + r - d; const bool valid = (unsigned)j < 64u; const int jc = valid ? j : 0;
                bf16x8 Bf[2];
#pragma unroll
                for (int kk = 0; kk < 2; ++kk) { bf16x8 t = *(const LAS bf16x8*)(lds + HY_ZS + b * 9216 + jc * 144 + kk * 64 + q * 16);
                    if (!valid) t = (bf16x8){0, 0, 0, 0, 0, 0, 0, 0};
                    Bf[kk] = t; }
#pragma unroll
                for (int kk = 0; kk < 2; ++kk)
#pragma unroll
                    for (int m = 0; m < 4; ++m) acc[m][nt] = __builtin_amdgcn_mfma_f32_16x16x32_bf16(Af[m - 2 * kk + 2], Bf[kk], acc[m][nt], 0, 0, 0);
            }
        }
    }
#pragma unroll
    for (int nt = 0; nt < 2; ++nt)
#pragma unroll
        for (int m = 0; m < 4; ++m) __builtin_nontemporal_store(acc[m][nt], (f32x4*)(CONVc + b * SEQ + 64 * (ib + 16 * nt + r) + 16 * m + 4 * q));
}

constexpr int AT_KS = 0, AT_KS_LD = 144, AT_VT = 384 * 144, AT_VT_LD = 784;
__device__ __forceinline__ void attn_unit(LAS unsigned char* lds, const bf16_t* PB, bf16_t* YAT, int u, const float* qg, const float* kg, const float* sink) {
    const int tid = threadIdx.x, lane = tid & 63, wid = tid >> 6, r = lane & 15, q = lane >> 4;
    const int b = u >> 7, nb = (u & 127) >> 2, kvh = u & 3;
    __syncthreads();
    u32x4 kraw[6], vraw[6];
#pragma unroll
    for (int k = 0; k < 6; ++k) { const int idx = tid + k * NTHREADS; const int key = idx >> 3, ch = idx & 7; const int kpos = 128 * (nb - 1) + key;
        const bool inr = kpos >= 0 && kpos < SEQ;
        const bf16_t* src = PB + (size_t)(b * SEQ + (inr ? kpos : 0)) * NPROJ + kvh * 64 + ch * 8;
        kraw[k] = *(const u32x4*)(src + 4096); vraw[k] = *(const u32x4*)(src + 4352); }
    const int g = wid >> 1, h = kvh * 4 + g;
    const bf16_t* qsrc = PB + (size_t)(b * SEQ + 128 * nb + (wid & 1) * 64 + r) * NPROJ + 3072 + h * 64 + q * 8;
    u32x4 qn0 = *(const u32x4*)(qsrc), qn1 = *(const u32x4*)(qsrc + 32);
#pragma unroll
    for (int k = 0; k < 6; ++k) { const int idx = tid + k * NTHREADS; const int key = idx >> 3, ch = idx & 7; const int kpos = 128 * (nb - 1) + key;
        const bool inr = kpos >= 0 && kpos < SEQ;
        u32x4 kv = kraw[k], vv = vraw[k];
        if (!inr) { kv = (u32x4){0u, 0u, 0u, 0u}; vv = kv; }
        float kf[8] = {bflo(kv.x), bfhi(kv.x), bflo(kv.y), bfhi(kv.y), bflo(kv.z), bfhi(kv.z), bflo(kv.w), bfhi(kv.w)};
        float ss = 0.f;
#pragma unroll
        for (int i = 0; i < 8; ++i) ss += kf[i] * kf[i];
        ss += __shfl_xor(ss, 1); ss += __shfl_xor(ss, 2); ss += __shfl_xor(ss, 4);
        const float rs = rsqrtf(ss * (1.0f / 64.0f) + EPS);
        const f32x4 g0 = *(const f32x4*)(kg + ch * 8), g1 = *(const f32x4*)(kg + ch * 8 + 4);
        const u32x4 ko = (u32x4){pk2(kf[0] * rs * g0[0], kf[1] * rs * g0[1]), pk2(kf[2] * rs * g0[2], kf[3] * rs * g0[3]), pk2(kf[4] * rs * g1[0], kf[5] * rs * g1[1]), pk2(kf[6] * rs * g1[2], kf[7] * rs * g1[3])};
        *(LAS u32x4*)(lds + AT_KS + key * AT_KS_LD + ch * 16) = ko;
        const unsigned vw[4] = {vv.x, vv.y, vv.z, vv.w};
#pragma unroll
        for (int i = 0; i < 8; ++i) *(LAS unsigned short*)(lds + AT_VT + (ch * 8 + i) * AT_VT_LD + key * 2) = (unsigned short)((i & 1) ? (vw[i >> 1] >> 16) : (vw[i >> 1] & 0xffffu));
    }
    __syncthreads();
    const float slope = exp2f(-0.5f * (float)(h + 1)), snk = sink[h];
    for (int si = 0; si < 4; ++si) {
        const int q0 = ((wid & 1) * 4 + si) * 16; const int qpos = 128 * nb + q0 + r;
        const u32x4 qc0 = qn0, qc1 = qn1;
        if (si < 3) { qn0 = *(const u32x4*)(qsrc + (size_t)(si + 1) * 16 * NPROJ); qn1 = *(const u32x4*)(qsrc + (size_t)(si + 1) * 16 * NPROJ + 32); }
        bf16x8 Qf[2];
        {
            const u32x4 a0 = qc0, a1 = qc1;
            float f0[8] = {bflo(a0.x), bfhi(a0.x), bflo(a0.y), bfhi(a0.y), bflo(a0.z), bfhi(a0.z), bflo(a0.w), bfhi(a0.w)};
            float f1[8] = {bflo(a1.x), bfhi(a1.x), bflo(a1.y), bfhi(a1.y), bflo(a1.z), bfhi(a1.z), bflo(a1.w), bfhi(a1.w)};
            float ss = 0.f;
#pragma unroll
            for (int i = 0; i < 8; ++i) ss += f0[i] * f0[i] + f1[i] * f1[i];
            ss += __shfl_xor(ss, 16); ss += __shfl_xor(ss, 32);
            const float rs = rsqrtf(ss * (1.0f / 64.0f) + EPS) * 0.125f;
            const f32x4 ga = *(const f32x4*)(qg + q * 8), gb = *(const f32x4*)(qg + q * 8 + 4), gc = *(const f32x4*)(qg + 32 + q * 8), gd = *(const f32x4*)(qg + 32 + q * 8 + 4);
            const u32x4 w0 = (u32x4){pk2(f0[0] * rs * ga[0], f0[1] * rs * ga[1]), pk2(f0[2] * rs * ga[2], f0[3] * rs * ga[3]), pk2(f0[4] * rs * gb[0], f0[5] * rs * gb[1]), pk2(f0[6] * rs * gb[2], f0[7] * rs * gb[3])};
            const u32x4 w1 = (u32x4){pk2(f1[0] * rs * gc[0], f1[1] * rs * gc[1]), pk2(f1[2] * rs * gc[2], f1[3] * rs * gc[3]), pk2(f1[4] * rs * gd[0], f1[5] * rs * gd[1]), pk2(f1[6] * rs * gd[2], f1[7] * rs * gd[3])};
            Qf[0] = __builtin_bit_cast(bf16x8, w0); Qf[1] = __builtin_bit_cast(bf16x8, w1);
        }
        const int kt0 = q0 >> 4;
        f32x4 S[17];
#pragma unroll
        for (int tt = 0; tt < 17; ++tt) {
            const LAS unsigned char* kp = lds + AT_KS + (16 * (kt0 + tt) + r) * AT_KS_LD + q * 16;
            const bf16x8 k0 = *(const LAS bf16x8*)kp, k1 = *(const LAS bf16x8*)(kp + 64);
            f32x4 s = __builtin_amdgcn_mfma_f32_16x16x32_bf16(k0, Qf[0], (f32x4){0.f, 0.f, 0.f, 0.f}, 0, 0, 0);
            S[tt] = __builtin_amdgcn_mfma_f32_16x16x32_bf16(k1, Qf[1], s, 0, 0, 0);
        }
        float mx = snk;
#pragma unroll
        for (int tt = 0; tt < 17; ++tt)
#pragma unroll
            for (int jj = 0; jj < 4; ++jj) { const int kl = 16 * (kt0 + tt) + 4 * q + jj; const int kpos = 128 * (nb - 1) + kl;
                int dist = 128 + q0 + r - kl; dist = dist < 0 ? -dist : dist;
                const bool valid = dist <= 128 && kpos >= 0 && kpos < SEQ;
                const float lg = valid ? S[tt][jj] - slope * (float)dist : -1e30f;
                S[tt][jj] = lg; mx = fmaxf(mx, lg); }
        mx = fmaxf(mx, __shfl_xor(mx, 16)); mx = fmaxf(mx, __shfl_xor(mx, 32));
        float sum = 0.f;
#pragma unroll
        for (int tt = 0; tt < 17; ++tt)
#pragma unroll
            for (int jj = 0; jj < 4; ++jj) { const float pe = __expf(S[tt][jj] - mx); S[tt][jj] = pe; sum += pe; }
        sum += __shfl_xor(sum, 16); sum += __shfl_xor(sum, 32);
        const float inv = 1.0f / (sum + __expf(snk - mx));
        f32x4 O[4];
#pragma unroll
        for (int dt = 0; dt < 4; ++dt) O[dt] = (f32x4){0.f, 0.f, 0.f, 0.f};
#pragma unroll
        for (int pr = 0; pr < 9; ++pr) {
            const int t0 = 2 * pr, t1 = 2 * pr + 1;
            u32x4 pw; pw.x = pk2(S[t0][0], S[t0][1]); pw.y = pk2(S[t0][2], S[t0][3]);
            if (t1 < 17) { pw.z = pk2(S[t1 < 17 ? t1 : 16][0], S[t1 < 17 ? t1 : 16][1]); pw.w = pk2(S[t1 < 17 ? t1 : 16][2], S[t1 < 17 ? t1 : 16][3]); } else { pw.z = 0u; pw.w = 0u; }
            const bf16x8 Pf = __builtin_bit_cast(bf16x8, pw);
#pragma unroll
            for (int dt = 0; dt < 4; ++dt) {
                const LAS unsigned char* vp = lds + AT_VT + (16 * dt + r) * AT_VT_LD + (16 * (kt0 + t0) + 4 * q) * 2;
                const u32x2 lo = *(const LAS u32x2*)vp; u32x2 hi = (u32x2){0u, 0u};
                if (t1 < 17) hi = *(const LAS u32x2*)(vp + 32);
                const bf16x8 Vf = __builtin_bit_cast(bf16x8, (u32x4){lo.x, lo.y, hi.x, hi.y});
                O[dt] = __builtin_amdgcn_mfma_f32_16x16x32_bf16(Vf, Pf, O[dt], 0, 0, 0);
            }
        }
        bf16_t* dst = YAT + (size_t)(b * SEQ + qpos) * 1024 + h * 64 + 4 * q;
#pragma unroll
        for (int dt = 0; dt < 4; ++dt) __builtin_nontemporal_store((u32x2){pk2(O[dt][0] * inv, O[dt][1] * inv), pk2(O[dt][2] * inv, O[dt][3] * inv)}, (u32x2*)(dst + 16 * dt));
    }
}

__device__ __forceinline__ void phase_mix(const Params& p, int l, LAS unsigned char* lds) {
    const int G = gridDim.x;
    const bf16_t* PB = (const bf16_t*)(p.ws + WS_PB);
    for (int c = blockIdx.x; c < 512; c += G)
        hyena_conv_unit(lds, (const bf16_t*)(p.ws + WS_KF) + ((size_t)l * 512 + c) * 8192, (const bf16_t*)(p.ws + WS_ZVT) + (size_t)c * 4 * SEQ, (float*)(p.ws + WS_CONVT) + (size_t)c * 4 * SEQ);
    for (int u = blockIdx.x; u < 512; u += G)
        attn_unit(lds, PB, (bf16_t*)(p.ws + WS_YAT), u, p.in[19] + l * 64, p.in[20] + l * 64, p.in[21] + l * 16);
    __syncthreads();
}

constexpr int PO_LD = 516;
__device__ __forceinline__ void ld8(const bf16_t* p, bool ok, float (&f)[8]) {
    u32x4 a = (u32x4){0u, 0u, 0u, 0u}; if (ok) a = *(const u32x4*)p;
    f[0] = bflo(a.x); f[1] = bfhi(a.x); f[2] = bflo(a.y); f[3] = bfhi(a.y); f[4] = bflo(a.z); f[5] = bfhi(a.z); f[6] = bflo(a.w); f[7] = bfhi(a.w);
}
__device__ __forceinline__ void phase_post(const Params& p, int l, LAS unsigned char* lds) {
    LAS float* Cs = (LAS float*)lds;
    const int tid = threadIdx.x, lane = tid & 63, wid = tid >> 6, G = gridDim.x;
    const bf16_t* PB = (const bf16_t*)(p.ws + WS_PB); const float* CONVT = (const float*)(p.ws + WS_CONVT); const bf16_t* YAT = (const bf16_t*)(p.ws + WS_YAT);
    bf16_t* YB = (bf16_t*)(p.ws + WS_YB);
    const float* sw = p.in[7] + l * 3 * 1536; const float* sb = p.in[8] + l * 1536; const float* bd = p.in[17] + l * 512; const float* cw = p.in[18] + l * 3 * 512;
    const int c = lane * 8;
    for (int u = blockIdx.x; u < MTOK / 32; u += G) {
        const int tg0 = u * 32, b = tg0 >> 12, tt = tg0 & 4095;
        __syncthreads();
#pragma unroll
        for (int k = 0; k < 8; ++k) { const int idx = tid + k * NTHREADS; const int cc = idx >> 3, ch = idx & 7;
            const f32x4 v = *(const f32x4*)(CONVT + ((size_t)cc * 4 + b) * SEQ + tt + ch * 4);
#pragma unroll
            for (int e = 0; e < 4; ++e) Cs[(ch * 4 + e) * PO_LD + cc] = v[e]; }
        __syncthreads();
        for (int ti = 0; ti < 4; ++ti) {
            const int tl = wid * 4 + ti, t = tt + tl;
            const bf16_t* row = PB + (size_t)(b * SEQ + t) * NPROJ;
            const bool okm = t > 0, okp = t < SEQ - 1;
            float yv[8];
            {
                float um[3][8];
#pragma unroll
                for (int part = 0; part < 3; ++part) {
                    float pm[8], pc[8], pp[8];
                    ld8(row - NPROJ + part * 512 + c, okm, pm); ld8(row + part * 512 + c, true, pc); ld8(row + NPROJ + part * 512 + c, okp, pp);
#pragma unroll
                    for (int hh = 0; hh < 2; ++hh) { const f32x4 w0 = *(const f32x4*)(sw + part * 512 + c + hh * 4), w1 = *(const f32x4*)(sw + 1536 + part * 512 + c + hh * 4), w2 = *(const f32x4*)(sw + 3072 + part * 512 + c + hh * 4), bb = *(const f32x4*)(sb + part * 512 + c + hh * 4);
#pragma unroll
                        for (int e = 0; e < 4; ++e) um[part][hh * 4 + e] = w0[e] * pm[hh * 4 + e] + w1[e] * pc[hh * 4 + e] + w2[e] * pp[hh * 4 + e] + bb[e]; }
                }
                const f32x4 c0 = *(const LAS f32x4*)(Cs + tl * PO_LD + c), c1 = *(const LAS f32x4*)(Cs + tl * PO_LD + c + 4);
                const f32x4 d0 = *(const f32x4*)(bd + c), d1 = *(const f32x4*)(bd + c + 4);
                float ss = 0.f;
#pragma unroll
                for (int e = 0; e < 8; ++e) { const float zv = um[2][e] * um[1][e]; const float cv = e < 4 ? c0[e] : c1[e - 4]; const float dd = e < 4 ? d0[e] : d1[e - 4];
                    yv[e] = um[0][e] * (cv + zv * dd); ss += yv[e] * yv[e]; }
                ss = wave_sum(ss);
                const float rs = rsqrtf(ss * (1.0f / 512.0f) + EPS);
                __builtin_nontemporal_store((u32x4){pk2(yv[0] * rs, yv[1] * rs), pk2(yv[2] * rs, yv[3] * rs), pk2(yv[4] * rs, yv[5] * rs), pk2(yv[6] * rs, yv[7] * rs)}, (u32x4*)(YB + (size_t)(b * SEQ + t) * DM + c));
            }
            {
                float gbv[8], cm[8], hm[8], cc0[8], hc[8], cp[8], hp[8];
                ld8(row + 1536 + c, true, gbv);
                ld8(row - NPROJ + 2048 + c, okm, cm); ld8(row - NPROJ + 2560 + c, okm, hm);
                ld8(row + 2048 + c, true, cc0); ld8(row + 2560 + c, true, hc);
                ld8(row + NPROJ + 2048 + c, okp, cp); ld8(row + NPROJ + 2560 + c, okp, hp);
                float ss = 0.f;
#pragma unroll
                for (int hh = 0; hh < 2; ++hh) { const f32x4 w0 = *(const f32x4*)(cw + c + hh * 4), w1 = *(const f32x4*)(cw + 512 + c + hh * 4), w2 = *(const f32x4*)(cw + 1024 + c + hh * 4);
#pragma unroll
                    for (int e = 0; e < 4; ++e) { const int k = hh * 4 + e; const float y = gbv[k] * (w0[e] * cm[k] * hm[k] + w1[e] * cc0[k] * hc[k] + w2[e] * cp[k] * hp[k]); yv[k] = y; ss += y * y; } }
                ss = wave_sum(ss);
                const float rs = rsqrtf(ss * (1.0f / 512.0f) + EPS);
                __builtin_nontemporal_store((u32x4){pk2(yv[0] * rs, yv[1] * rs), pk2(yv[2] * rs, yv[3] * rs), pk2(yv[4] * rs, yv[5] * rs), pk2(yv[6] * rs, yv[7] * rs)}, (u32x4*)(YB + (size_t)(b * SEQ + t) * DM + 512 + c));
            }
            {
                float a0[8], a1[8];
                const bf16_t* ya = YAT + (size_t)(b * SEQ + t) * 1024;
                ld8(ya + c, true, a0); ld8(ya + 512 + c, true, a1);
                float ss = 0.f;
#pragma unroll
                for (int e = 0; e < 8; ++e) ss += a0[e] * a0[e] + a1[e] * a1[e];
                ss = wave_sum(ss);
                const float rs = rsqrtf(ss * (1.0f / 1024.0f) + EPS);
                bf16_t* yo = YB + (size_t)(b * SEQ + t) * DM + 1024;
                __builtin_nontemporal_store((u32x4){pk2(a0[0] * rs, a0[1] * rs), pk2(a0[2] * rs, a0[3] * rs), pk2(a0[4] * rs, a0[5] * rs), pk2(a0[6] * rs, a0[7] * rs)}, (u32x4*)(yo + c));
                __builtin_nontemporal_store((u32x4){pk2(a1[0] * rs, a1[1] * rs), pk2(a1[2] * rs, a1[3] * rs), pk2(a1[4] * rs, a1[5] * rs), pk2(a1[6] * rs, a1[7] * rs)}, (u32x4*)(yo + 512 + c));
            }
        }
    }
    __syncthreads();
}

#define XB_TMO      128
#define XB_XCNT(j)  (256  + 64 * (j))
#define XB_XSUB(j)  (1280 + 64 * (j))
#define XB_XGEN(j)  (2304 + 64 * (j))
#define XB_TOP      3328
#define XB_TOPGEN   3392
#define XCD_BAR_WORDS 3456
#define XB_SPIN_CAP (1u << 18)

__device__ __forceinline__ unsigned xb_ld(unsigned* p)              { return __hip_atomic_load(p, __ATOMIC_RELAXED, __HIP_MEMORY_SCOPE_AGENT); }
__device__ __forceinline__ unsigned xb_add(unsigned* p, unsigned v) { return __hip_atomic_fetch_add(p, v, __ATOMIC_RELAXED, __HIP_MEMORY_SCOPE_AGENT); }
__device__ __forceinline__ unsigned xb_xcc_id() { return (unsigned)__builtin_amdgcn_s_getreg((3 << 11) | 20) & 0xFu; }
#define XB_SPIN(cond, bar) do { unsigned _sp = 0; while (cond) { __builtin_amdgcn_s_sleep(1); \
    if ((++_sp & 255u) == 0u) { if (xb_ld(&(bar)[XB_TMO])) break; if (_sp > XB_SPIN_CAP) { atomicAdd(&(bar)[XB_TMO], 1u); break; } } } } while (0)

struct XcdBarrier {
    unsigned* bar; unsigned x;
    volatile LAS unsigned* st;
};

__device__ __forceinline__ XcdBarrier xcd_barrier_post(unsigned* bar, volatile LAS unsigned* st) {
    XcdBarrier b; b.bar = bar; b.x = xb_xcc_id(); b.st = st;
    if (threadIdx.x == 0) (void)xb_add(&bar[XB_XCNT(b.x)], 1u);
    return b;
}
__device__ __forceinline__ void xcd_barrier_complete(unsigned* bar, unsigned x, unsigned& nloc, unsigned& nx) {
    const unsigned G = gridDim.x * gridDim.y * gridDim.z;
    unsigned sum, cnt, mine, sp = 0u;
    for (;;) {
        sum = 0u; cnt = 0u; mine = 0u;
#pragma unroll
        for (unsigned j = 0; j < 16; ++j) { const unsigned c = xb_ld(&bar[XB_XCNT(j)]); sum += c; cnt += (c > 0u) ? 1u : 0u; mine = (j == x) ? c : mine; }
        if (sum == G) break;
        __builtin_amdgcn_s_sleep(1);
        if ((++sp & 255u) == 0u) { if (xb_ld(&bar[XB_TMO])) break; if (sp > XB_SPIN_CAP) { atomicAdd(&bar[XB_TMO], 1u); break; } }
    }
    nloc = mine > 0u ? mine : 1u; nx = cnt > 0u ? cnt : 1u;
}

__device__ __forceinline__ void xcd_barrier(const XcdBarrier& b) {
    asm volatile("s_waitcnt vmcnt(0)" ::: "memory");
    __syncthreads();
    if (threadIdx.x == 0) {
        unsigned* bar = b.bar;
        __builtin_amdgcn_s_waitcnt(0);
        unsigned nloc = b.st[0], nx = b.st[1];
        if (nloc == 0u) { xcd_barrier_complete(bar, b.x, nloc, nx); b.st[0] = nloc; b.st[1] = nx; }
        const unsigned old = xb_add(&bar[XB_XSUB(b.x)], 1u);
        const unsigned gen = old / nloc;
        if (old + 1u == (gen + 1u) * nloc) {
            __builtin_amdgcn_fence(__ATOMIC_RELEASE, "agent");
            asm volatile("s_waitcnt vmcnt(0)" ::: "memory");
            const unsigned og = xb_add(&bar[XB_TOP], 1u);
            const unsigned tg = og / nx;
            if (og + 1u == (tg + 1u) * nx) xb_add(&bar[XB_TOPGEN], 1u);
            else XB_SPIN(xb_ld(&bar[XB_TOPGEN]) == tg, bar);
            __builtin_amdgcn_fence(__ATOMIC_ACQUIRE, "agent");
            xb_add(&bar[XB_XGEN(b.x)], 1u);
            asm volatile("s_waitcnt vmcnt(0)" ::: "memory");
        } else {
            XB_SPIN(xb_ld(&bar[XB_XGEN(b.x)]) == gen, bar);
            __builtin_amdgcn_fence(__ATOMIC_ACQUIRE, "agent");
            asm volatile("s_waitcnt vmcnt(0)" ::: "memory");
        }
    }
    __syncthreads();
}


template <class Epi> __device__ __forceinline__ void run_gemm(LAS unsigned char* lds, const bf16_t* A, const bf16_t* Bt, int N, int K, const Epi& E) {
    pg8::Gemm g{A, Bt, MTOK, N, K}; pg8::StaticOrder S; S.init(MTOK, N, (int)gridDim.x, (int)blockIdx.x);
    pg8::gemm_phase<Epi, pg8::StaticOrder, false>(lds, g, S, E, nullptr);
}

constexpr int N_PHASES = 19;
#define IN(k) (lo <= (k) && (k) < hi)
#define SEAM(k) do { if (IN(k) && IN((k) + 1)) { if (lo < 0) grid.sync(); else xcd_barrier(bar); } } while (0)
template <int L> __device__ __forceinline__ void layer_fwd(const Params& p, LAS unsigned char* lds, cg::grid_group& grid, const XcdBarrier& bar, const int lo, const int hi) {
    unsigned char* ws = p.ws;
    bf16_t* XB = (bf16_t*)(ws + WS_HB); bf16_t* ACT = (bf16_t*)(ws + WS_ACT); bf16_t* PB = (bf16_t*)(ws + WS_PB); bf16_t* YB = (bf16_t*)(ws + WS_YB);
    unsigned long long* SS = (unsigned long long*)(ws + WS_SS) + (size_t)(3 * L) * MTOK;
    constexpr int P0 = 1 + 9 * L;
    if (IN(P0 + 0)) { pg8::EpiGU E{ACT, DFF, SS}; run_gemm(lds, XB, (const bf16_t*)(ws + WS_WGU + (size_t)(L * 2 + 0) * SZ_WGU), 2 * DFF, DM, E); } SEAM(P0 + 0);
    if (IN(P0 + 1)) { pg8::EpiResB E{XB, nullptr, DM, 0.5f, SS + MTOK}; run_gemm(lds, ACT, (const bf16_t*)(ws + WS_WDN + (size_t)(L * 2 + 0) * SZ_WDN), DM, DFF, E); } SEAM(P0 + 1);
    if (IN(P0 + 2)) { pg8::EpiB16 E{PB, NPROJ, SS + MTOK}; run_gemm(lds, XB, (const bf16_t*)(ws + WS_WIN + (size_t)L * SZ_WIN), NPROJ, DM, E); } SEAM(P0 + 2);
    if (IN(P0 + 3)) { phase_hyprep(p, L); } SEAM(P0 + 3);
    if (IN(P0 + 4)) { phase_mix(p, L, lds); } SEAM(P0 + 4);
    if (IN(P0 + 5)) { phase_post(p, L, lds); } SEAM(P0 + 5);
    if (IN(P0 + 6)) { pg8::EpiResB E{XB, nullptr, DM, 1.0f, SS + 2 * MTOK}; run_gemm(lds, YB, (const bf16_t*)(ws + WS_WOUT + (size_t)L * SZ_WOUT), DM, DM, E); } SEAM(P0 + 6);
    if (IN(P0 + 7)) { pg8::EpiGU E{ACT, DFF, SS + 2 * MTOK}; run_gemm(lds, XB, (const bf16_t*)(ws + WS_WGU + (size_t)(L * 2 + 1) * SZ_WGU), 2 * DFF, DM, E); } SEAM(P0 + 7);
    if (IN(P0 + 8)) { pg8::EpiResB E{XB, L == 1 ? p.out : nullptr, DM, 0.5f, L == 1 ? nullptr : SS + 3 * MTOK}; run_gemm(lds, ACT, (const bf16_t*)(ws + WS_WDN + (size_t)(L * 2 + 1) * SZ_WDN), DM, DFF, E); }
    if (L == 0) SEAM(P0 + 8);
}
__global__ void __launch_bounds__(NTHREADS, 2) mega_fwd(Params p) {
    extern __shared__ __attribute__((aligned(16))) unsigned char shm[];
    LAS unsigned char* lds = (LAS unsigned char*)shm;
    cg::grid_group grid = cg::this_grid();
    const int lo = p.ph_lo, hi = p.ph_hi;
    if (threadIdx.x < 4) ((LAS unsigned*)(lds + BAR_LDS_OFF))[threadIdx.x] = 0u;
    __syncthreads();
    const XcdBarrier bar = xcd_barrier_post((unsigned*)(p.ws + WS_BAR), (volatile LAS unsigned*)(lds + BAR_LDS_OFF));
    if (IN(0)) { phase_x0(p.in[0], (bf16_t*)(p.ws + WS_HB), (unsigned long long*)(p.ws + WS_SS)); phase_filter(p, lds); phase_convert(p, lds); } SEAM(0);
    layer_fwd<0>(p, lds, grid, bar, lo, hi);
    layer_fwd<1>(p, lds, grid, bar, lo, hi);
}

extern "C" void kernel_launch(void* const* d_in, const int* in_sizes, int n_in, void* d_out, int out_size, void* d_ws, size_t ws_size, hipStream_t stream) {
    static int grid = 0;
    if (grid == 0) {
        if (n_in != 28 || in_sizes[0] != MTOK * DM || out_size != MTOK * DM || ws_size < WS_END) { fprintf(stderr, "kernel_launch: unexpected shapes / workspace (n_in %d, ws %zu < %zu)\n", n_in, ws_size, (size_t)WS_END); grid = -1; return; }
        int dev = 0, cus = 0, per_cu = 0;
        hipGetDevice(&dev); hipDeviceGetAttribute(&cus, hipDeviceAttributeMultiprocessorCount, dev);
        if (hipFuncSetAttribute((const void*)mega_fwd, hipFuncAttributeMaxDynamicSharedMemorySize, LDS_BYTES) != hipSuccess) { fprintf(stderr, "kernel_launch: hipFuncSetAttribute failed\n"); grid = -1; return; }
        if (hipOccupancyMaxActiveBlocksPerMultiprocessor(&per_cu, (const void*)mega_fwd, NTHREADS, LDS_BYTES) != hipSuccess || per_cu < 1) { fprintf(stderr, "kernel_launch: occupancy query gave %d\n", per_cu); per_cu = 1; }
        (void)hipGetLastError();
        grid = cus * per_cu;
    }
    if (grid < 0) return;
    Params p{};
    for (int i = 0; i < 28; ++i) p.in[i] = (const float*)d_in[i];
    p.out = (float*)d_out; p.ws = (unsigned char*)d_ws;
    (void)hipMemsetAsync((unsigned char*)d_ws + WS_BAR, 0, 16384, stream);
#if defined(MK_PER_PHASE)
    for (int ph = 0; ph < N_PHASES; ++ph) { p.ph_lo = ph; p.ph_hi = ph + 1; hipLaunchKernelGGL(mega_fwd, dim3(grid), dim3(NTHREADS), LDS_BYTES, stream, p); }
#else
    p.ph_lo = 0; p.ph_hi = N_PHASES;
    void* args[] = {&p};
    hipError_t e = hipLaunchCooperativeKernel((const void*)mega_fwd, dim3(grid), dim3(NTHREADS), args, LDS_BYTES, stream);
    if (e != hipSuccess) fprintf(stderr, "cooperative launch failed: %s (grid %d)\n", hipGetErrorString(e), grid);
#endif
}
```

```cpp
#include <hip/hip_runtime.h>
#include <hip/hip_cooperative_groups.h>
#include <cstdio>
namespace cg = cooperative_groups;
#include <hip/hip_runtime.h>
namespace pg8 {
#define PG8_LAS __attribute__((address_space(3)))
typedef unsigned short bf16_t;
typedef short bf16x8 __attribute__((ext_vector_type(8)));
typedef float f32x4 __attribute__((ext_vector_type(4)));
typedef unsigned u32x4 __attribute__((ext_vector_type(4)));
constexpr int BM = 256, BK = 64, HALF = 128, HTB = HALF * BK * 2  , STAGE_BYTES = 8 * HTB, NXCD = 8, WGM = 8;

__host__ __device__ __forceinline__ int lds_byte(int r, int c) { const int st = (r >> 4) * 2 + (c >> 5), rr = r & 15, cc = c & 31, ob = rr * 64 + cc * 2; return st * 1024 + (ob ^ (((ob >> 9) & 1) << 5)); }
__host__ __device__ __forceinline__ void stage_rc(int b, int& R, int& C) { const int st = b / 1024, sb = b % 1024, swz = sb ^ (((sb >> 9) & 1) << 5); R = (st >> 1) * 16 + swz / 64; C = (st & 1) * 32 + (swz % 64) / 2; }
__host__ __device__ __forceinline__ int perm32(int rho) { const int n = rho >> 4, i = rho & 15; return 8 * (i >> 2) + 4 * n + (i & 3); }

struct Unit { int pm, pn; };
struct Gemm { const bf16_t* A; const bf16_t* Bt; int M, N, K; };

struct StaticOrder {
    int nM, nN, nwg, G, c;
    __host__ __device__ void init(int M, int N, int G_, int c_) { nM = M / BM; nN = N / BM; nwg = nM * nN; G = G_; c = c_; }
    __host__ __device__ bool next(int i, Unit& u) const {
        const long L = (long)i * G + c; if (L >= nwg) return false;
        int wgid = (int)L; { const int q = nwg / NXCD, r = nwg % NXCD, xcd = wgid % NXCD, off = wgid / NXCD; wgid = (xcd < r ? xcd * (q + 1) : r * (q + 1) + (xcd - r) * q) + off; }
        const int nig = WGM * nN, gid = wgid / nig, fm = gid * WGM, gsz = (nM - fm) < WGM ? (nM - fm) : WGM;
        u.pm = fm + ((wgid % nig) % gsz); u.pn = (wgid % nig) / gsz; return true;
    }
    __device__ __forceinline__ void a_ready(const Unit&) const {}
    __device__ __forceinline__ void done(const Unit&) const {}
};
__device__ __forceinline__ unsigned cvt_pk_bf16(float lo, float hi) { unsigned r; asm volatile("v_cvt_pk_bf16_f32 %0, %1, %2" : "=v"(r) : "v"(lo), "v"(hi)); return r; }

__device__ __forceinline__ void row_rstd(const unsigned long long* ss, int row0, float (&rs)[2][4]) {
#pragma unroll
    for (int ai = 0; ai < 2; ++ai)
#pragma unroll
        for (int m = 0; m < 4; ++m) rs[ai][m] = ss ? __builtin_amdgcn_rsqf((float)ss[row0 + ai * HALF + m * 16] * (1.0f / (2048.0f * 1048576.0f)) + 1e-6f) : 1.0f;
}
struct EpiB16 {
    static constexpr bool PERM = true, AFTER_DRAIN = false;
    bf16_t* O; int ldc; const unsigned long long* ss;
    __device__ __forceinline__ void operator()(const f32x4 (&acc)[2][2][4][2], const Unit& u, int wr, int wc, int fr, int fq) const {
        const int row0 = u.pm * BM + wr * 64 + fr, col0 = u.pn * BM + wc * 32 + 8 * fq;
        float rs[2][4]; row_rstd(ss, row0, rs);
#pragma unroll
        for (int ai = 0; ai < 2; ++ai)
#pragma unroll
            for (int m = 0; m < 4; ++m) { bf16_t* rowp = O + (size_t)(row0 + ai * HALF + m * 16) * ldc + col0;
#pragma unroll
                for (int bj = 0; bj < 2; ++bj) { const f32x4 v0 = acc[ai][bj][m][0] * rs[ai][m], v1 = acc[ai][bj][m][1] * rs[ai][m];
                    u32x4 w; w.x = cvt_pk_bf16(v0[0], v0[1]); w.y = cvt_pk_bf16(v0[2], v0[3]); w.z = cvt_pk_bf16(v1[0], v1[1]); w.w = cvt_pk_bf16(v1[2], v1[3]);
                    *(u32x4*)(rowp + bj * HALF) = w; } }
    }
};
__device__ __forceinline__ float silu_mul(float g, float u) { return g * u * __builtin_amdgcn_rcpf(1.0f + __builtin_amdgcn_exp2f(-1.44269504089f * g)); }
struct EpiGU {
    static constexpr bool PERM = true, AFTER_DRAIN = false;
    bf16_t* O; int ldc; const unsigned long long* ss;
    __device__ __forceinline__ void operator()(const f32x4 (&acc)[2][2][4][2], const Unit& u, int wr, int wc, int fr, int fq) const {
        const int row0 = u.pm * BM + wr * 64 + fr, col0 = u.pn * HALF + wc * 32 + 8 * fq;
        float rs[2][4]; row_rstd(ss, row0, rs);
#pragma unroll
        for (int ai = 0; ai < 2; ++ai)
#pragma unroll
            for (int m = 0; m < 4; ++m) { bf16_t* rowp = O + (size_t)(row0 + ai * HALF + m * 16) * ldc + col0;
                const f32x4 g0 = acc[ai][0][m][0] * rs[ai][m], g1 = acc[ai][0][m][1] * rs[ai][m], u0 = acc[ai][1][m][0] * rs[ai][m], u1 = acc[ai][1][m][1] * rs[ai][m];
                u32x4 w;
                w.x = cvt_pk_bf16(silu_mul(g0[0], u0[0]), silu_mul(g0[1], u0[1])); w.y = cvt_pk_bf16(silu_mul(g0[2], u0[2]), silu_mul(g0[3], u0[3]));
                w.z = cvt_pk_bf16(silu_mul(g1[0], u1[0]), silu_mul(g1[1], u1[1])); w.w = cvt_pk_bf16(silu_mul(g1[2], u1[2]), silu_mul(g1[3], u1[3]));
                *(u32x4*)rowp = w; }
    }
};
struct EpiResB {
    static constexpr bool PERM = true, AFTER_DRAIN = false;
    bf16_t* XB; float* OUT; int ldc; float scale; unsigned long long* ss_out;
    __device__ __forceinline__ void operator()(const f32x4 (&acc)[2][2][4][2], const Unit& u, int wr, int wc, int fr, int fq) const {
        const int row0 = u.pm * BM + wr * 64 + fr, col0 = u.pn * BM + wc * 32 + 8 * fq;
#pragma unroll
        for (int ai = 0; ai < 2; ++ai) {
            u32x4 xo[4][2];
#pragma unroll
            for (int m = 0; m < 4; ++m)
#pragma unroll
                for (int bj = 0; bj < 2; ++bj) xo[m][bj] = *(const u32x4*)(XB + (size_t)(row0 + ai * HALF + m * 16) * ldc + col0 + bj * HALF);
#pragma unroll
            for (int m = 0; m < 4; ++m) { const size_t off = (size_t)(row0 + ai * HALF + m * 16) * ldc + col0; float sq = 0.f;
#pragma unroll
                for (int bj = 0; bj < 2; ++bj) { const u32x4 x = xo[m][bj];
                    const f32x4 v0 = (f32x4){__uint_as_float(x.x << 16), __uint_as_float(x.x & 0xffff0000u), __uint_as_float(x.y << 16), __uint_as_float(x.y & 0xffff0000u)} + acc[ai][bj][m][0] * scale;
                    const f32x4 v1 = (f32x4){__uint_as_float(x.z << 16), __uint_as_float(x.z & 0xffff0000u), __uint_as_float(x.w << 16), __uint_as_float(x.w & 0xffff0000u)} + acc[ai][bj][m][1] * scale;
                    sq += v0[0] * v0[0] + v0[1] * v0[1] + v0[2] * v0[2] + v0[3] * v0[3] + v1[0] * v1[0] + v1[1] * v1[1] + v1[2] * v1[2] + v1[3] * v1[3];
                    if (OUT) { *(f32x4*)(OUT + off + bj * HALF) = v0; *(f32x4*)(OUT + off + bj * HALF + 4) = v1; }
                    else { u32x4 w; w.x = cvt_pk_bf16(v0[0], v0[1]); w.y = cvt_pk_bf16(v0[2], v0[3]); w.z = cvt_pk_bf16(v1[0], v1[1]); w.w = cvt_pk_bf16(v1[2], v1[3]); *(u32x4*)(XB + off + bj * HALF) = w; } }
                if (ss_out) { sq += __shfl_xor(sq, 16); sq += __shfl_xor(sq, 32); if (fq == 0) atomicAdd(ss_out + row0 + ai * HALF + m * 16, (unsigned long long)(sq * 1048576.0f)); } }
        }
    }
};

template <class Epi, class Sched, bool STAMP = false>
__device__ __forceinline__ void gemm_phase(PG8_LAS unsigned char* lds, const Gemm g, const Sched& S, const Epi& E, unsigned long long* stamps) {
    const int tid = threadIdx.x, wid = __builtin_amdgcn_readfirstlane(tid >> 6), lane = tid & 63, wr = wid >> 2, wc = wid & 3, fr = lane & 15, fq = lane >> 4;
    const int K = g.K, nt = K / BK;
    int ts_lo = 0, ts_hi = 0, nts = 0; const unsigned long long rt_entry = STAMP ? (unsigned long long)wall_clock64() : 0ull;
#define PG8_STAMP() do { if (STAMP && wid == 0 && nts < 64) { const unsigned long long _c = (unsigned long long)clock64(); \
        ts_lo = (lane == nts) ? (int)(unsigned)_c : ts_lo; ts_hi = (lane == nts) ? (int)(unsigned)(_c >> 32) : ts_hi; ++nts; } } while (0)
    PG8_STAMP();
    unsigned voffA[2], voffB[2];
#pragma unroll
    for (int i = 0; i < 2; ++i) { int R, C; stage_rc(tid * 16 + i * 8192, R, C); const int Rb = Epi::PERM ? ((R & ~31) + perm32(R & 31)) : R;
        voffA[i] = (unsigned)(R * K + C) * 2u; voffB[i] = (unsigned)(Rb * K + C) * 2u; }
    const size_t kstep = (size_t)(BK * 2);
    const size_t hstep = (size_t)HALF * K * 2;
    const size_t tstep = 2 * hstep;
    const unsigned ldsw = (unsigned)wid * 1024u;
    const int aoff = lds_byte(wr * 64 + fr, fq * 8), boff = lds_byte(wc * 32 + fr, fq * 8);
#define PG8_SA(b, h) (((b) * 2 + (h)) * HTB)
#define PG8_SB(b, h) ((4 + (b) * 2 + (h)) * HTB)
#define PG8_STAGE(bufoff, gbase, voff) do { _Pragma("unroll") for (int _i = 0; _i < 2; ++_i) \
        __builtin_amdgcn_global_load_lds((const unsigned*)((const char*)(gbase) + (voff)[_i]), (PG8_LAS unsigned*)(lds + (bufoff) + ldsw + _i * 8192), 16, 0, 0); } while (0)
#define PG8_LDA(dst, b, h) do { _Pragma("unroll") for (int m = 0; m < 4; ++m) _Pragma("unroll") for (int k = 0; k < 2; ++k) dst[m][k] = *(const PG8_LAS bf16x8*)(lds + PG8_SA(b, h) + aoff + m * 2048 + k * 1024); } while (0)
#define PG8_LDB(dst, b, h) do { _Pragma("unroll") for (int n = 0; n < 2; ++n) _Pragma("unroll") for (int k = 0; k < 2; ++k) dst[n][k] = *(const PG8_LAS bf16x8*)(lds + PG8_SB(b, h) + boff + n * 2048 + k * 1024); } while (0)
#define PG8_MMA(ai, bj, At, Bt) do { __builtin_amdgcn_s_setprio(1); _Pragma("unroll") for (int m = 0; m < 4; ++m) _Pragma("unroll") for (int n = 0; n < 2; ++n) _Pragma("unroll") for (int k = 0; k < 2; ++k) \
        acc[ai][bj][m][n] = __builtin_amdgcn_mfma_f32_16x16x32_bf16(Bt[n][k], At[m][k], acc[ai][bj][m][n], 0, 0, 0); __builtin_amdgcn_s_setprio(0); } while (0)
#define PG8_WAIT_V(n) asm volatile("s_waitcnt vmcnt(" #n ")" ::: "memory")
#define PG8_WAIT_L(n) asm volatile("s_waitcnt lgkmcnt(" #n ")" ::: "memory")
#define PG8_BAR __builtin_amdgcn_s_barrier()
#define PG8_SCHED __builtin_amdgcn_sched_barrier(0)
    Unit cur, nxt; int ui = 0;
    if (!S.next(0, cur)) return;
    f32x4 acc[2][2][4][2];
#pragma unroll
    for (int a = 0; a < 2; ++a)
#pragma unroll
        for (int b = 0; b < 2; ++b)
#pragma unroll
            for (int m = 0; m < 4; ++m)
#pragma unroll
                for (int n = 0; n < 2; ++n) acc[a][b][m][n] = (f32x4){0.f, 0.f, 0.f, 0.f};
    bf16x8 At[4][2], B0[2][2], B1[2][2];
    const char* cA = (const char*)g.A + (size_t)cur.pm * tstep; const char* cB = (const char*)g.Bt + (size_t)cur.pn * tstep;
    S.a_ready(cur);
    PG8_STAGE(PG8_SB(0, 0), cB, voffB); PG8_STAGE(PG8_SA(0, 0), cA, voffA); PG8_STAGE(PG8_SB(0, 1), cB + hstep, voffB); PG8_STAGE(PG8_SA(0, 1), cA + hstep, voffA);
    if (wr == 1) PG8_BAR;
    PG8_WAIT_V(4); PG8_BAR;
    PG8_STAGE(PG8_SB(1, 0), cB + kstep, voffB); PG8_STAGE(PG8_SA(1, 0), cA + kstep, voffA); PG8_STAGE(PG8_SB(1, 1), cB + hstep + kstep, voffB);
    PG8_WAIT_V(6); PG8_BAR;
    PG8_STAMP();
    for (;;) {
        const bool has_next = S.next(ui + 1, nxt);
        const char* nA = has_next ? (const char*)g.A + (size_t)nxt.pm * tstep : cA; const char* nB = has_next ? (const char*)g.Bt + (size_t)nxt.pn * tstep : cB;
        for (int t = 0; t < nt; t += 2) {
            const bool last = (t == nt - 2);
            const char* a1 = cA + (size_t)(t + 1) * kstep;
            const char* a2 = last ? nA : cA + (size_t)(t + 2) * kstep; const char* b2 = last ? nB : cB + (size_t)(t + 2) * kstep;
            const char* a3 = a2 + kstep; const char* b3 = b2 + kstep;
            if (last && has_next) S.a_ready(nxt);
            PG8_LDB(B0, 0, 0); PG8_SCHED; PG8_LDA(At, 0, 0); PG8_STAGE(PG8_SA(1, 1), a1 + hstep, voffA);
            PG8_WAIT_L(8); PG8_BAR; PG8_WAIT_L(0); PG8_MMA(0, 0, At, B0); PG8_BAR; PG8_SCHED;
            PG8_LDB(B1, 0, 1); PG8_STAGE(PG8_SB(0, 0), b2, voffB);
            PG8_BAR; PG8_WAIT_L(0); PG8_MMA(0, 1, At, B1); PG8_BAR;
            PG8_LDA(At, 0, 1); PG8_STAGE(PG8_SA(0, 0), a2, voffA);
            PG8_BAR; PG8_WAIT_L(0); PG8_MMA(1, 0, At, B0); PG8_BAR; PG8_SCHED;
            PG8_STAGE(PG8_SB(0, 1), b2 + hstep, voffB);
            PG8_WAIT_V(6); PG8_BAR; PG8_MMA(1, 1, At, B1); PG8_BAR;
            PG8_LDB(B0, 1, 0); PG8_SCHED; PG8_LDA(At, 1, 0); PG8_STAGE(PG8_SA(0, 1), a2 + hstep, voffA);
            PG8_WAIT_L(8); PG8_BAR; PG8_WAIT_L(0); PG8_MMA(0, 0, At, B0); PG8_BAR; PG8_SCHED;
            PG8_LDB(B1, 1, 1); PG8_STAGE(PG8_SB(1, 0), b3, voffB);
            PG8_BAR; PG8_WAIT_L(0); PG8_MMA(0, 1, At, B1); PG8_BAR;
            PG8_LDA(At, 1, 1); PG8_STAGE(PG8_SA(1, 0), a3, voffA);
            PG8_BAR; PG8_WAIT_L(0); PG8_MMA(1, 0, At, B0); PG8_BAR; PG8_SCHED;
            PG8_STAGE(PG8_SB(1, 1), b3 + hstep, voffB);
            PG8_WAIT_V(6); PG8_BAR; PG8_MMA(1, 1, At, B1); PG8_BAR;
        }
        PG8_STAMP();
        if constexpr (!Epi::AFTER_DRAIN) { E(acc, cur, wr, wc, fr, fq); S.done(cur); }
        PG8_STAMP();
        if (!has_next) break;
#pragma unroll
        for (int a = 0; a < 2; ++a)
#pragma unroll
            for (int b = 0; b < 2; ++b)
#pragma unroll
                for (int m = 0; m < 4; ++m)
#pragma unroll
                    for (int n = 0; n < 2; ++n) acc[a][b][m][n] = (f32x4){0.f, 0.f, 0.f, 0.f};
        cur = nxt; cA = nA; cB = nB; ++ui;
    }
    PG8_WAIT_V(0);
    if (wr == 0) PG8_BAR;
    PG8_BAR;
    if constexpr (Epi::AFTER_DRAIN) { E.fused(acc, cur, wr, wc, fr, fq, lds, wid, lane); S.done(cur); }
    PG8_STAMP();
    if (STAMP && wid == 0) { stamps[lane] = lane < nts ? (((unsigned long long)(unsigned)ts_hi << 32) | (unsigned)ts_lo) : 0ull;
        if (lane == 62) stamps[62] = rt_entry; if (lane == 63) stamps[63] = (unsigned long long)wall_clock64(); }
#undef PG8_STAMP
#undef PG8_SA
#undef PG8_SB
#undef PG8_STAGE
#undef PG8_LDA
#undef PG8_LDB
#undef PG8_MMA
#undef PG8_WAIT_V
#undef PG8_WAIT_L
#undef PG8_BAR
#undef PG8_SCHED
}
}

#define LAS __attribute__((address_space(3)))
typedef unsigned short bf16_t;
typedef short bf16x8 __attribute__((ext_vector_type(8)));
typedef float f32x4 __attribute__((ext_vector_type(4)));
typedef unsigned u32x4 __attribute__((ext_vector_type(4)));
typedef unsigned u32x2 __attribute__((ext_vector_type(2)));

constexpr int MTOK = 16384, DM = 2048, DFF = 5632, NPROJ = 4608, SEQ = 4096, NB = 4;
constexpr int NTHREADS = 512;
constexpr int BAR_LDS_OFF = 131072;
constexpr int LDS_BYTES = 131072 + 256;
constexpr float EPS = 1e-6f;

constexpr size_t SZ_WGU = (size_t)2 * DFF * DM * 2, SZ_WDN = (size_t)DM * DFF * 2, SZ_WIN = (size_t)NPROJ * DM * 2, SZ_WOUT = (size_t)DM * DM * 2;
constexpr size_t WS_WGU = 0;
constexpr size_t WS_WDN = WS_WGU + 4 * SZ_WGU;
constexpr size_t WS_WIN = WS_WDN + 4 * SZ_WDN;
constexpr size_t WS_WOUT = WS_WIN + 2 * SZ_WIN;
constexpr size_t WS_KF = WS_WOUT + 2 * SZ_WOUT;
constexpr size_t WS_HB = WS_KF + (size_t)2 * 512 * 8192 * 2;
constexpr size_t WS_UN = WS_HB + (size_t)MTOK * DM * 2;
constexpr size_t WS_ACT = WS_UN;
constexpr size_t WS_PB = WS_UN;
constexpr size_t WS_ZVT = WS_PB + (size_t)MTOK * NPROJ * 2;
constexpr size_t WS_CONVT = WS_ZVT + (size_t)512 * 4 * 4096 * 2;
constexpr size_t WS_YAT = WS_CONVT + (size_t)512 * 4 * 4096 * 4;
constexpr size_t WS_YB = WS_YAT + (size_t)MTOK * 1024 * 2;
constexpr size_t WS_SS = WS_YB + (size_t)MTOK * DM * 2;
constexpr size_t WS_BAR = WS_SS + (size_t)6 * MTOK * 8;
constexpr size_t WS_END = WS_BAR + 16384;
static_assert(WS_END - WS_UN >= (size_t)MTOK * DFF * 2, "union region must hold ACT");

struct Params { const float* in[28]; float* out; unsigned char* ws; int ph_lo, ph_hi; };

__device__ __forceinline__ float bf2f(unsigned short b) { return __uint_as_float(((unsigned)b) << 16); }
__device__ __forceinline__ float bflo(unsigned w) { return __uint_as_float(w << 16); }
__device__ __forceinline__ float bfhi(unsigned w) { return __uint_as_float(w & 0xffff0000u); }
__device__ __forceinline__ unsigned pk2(float lo, float hi) { return pg8::cvt_pk_bf16(lo, hi); }
__device__ __forceinline__ float wave_sum(float v) {
#pragma unroll
    for (int o = 32; o >= 1; o >>= 1) v += __shfl_xor(v, o);
    return v;
}

constexpr int CV_TK = 64, CV_TN = 256, CV_LD = 260;
struct CvJob { const float* src; const float* gain; bf16_t* dst; int K, N, mode; };
constexpr int CV_T_GU = (DM / CV_TK) * (DFF / CV_TN), CV_T_DN = (DFF / CV_TK) * (DM / CV_TN), CV_T_IN = (DM / CV_TK) * (NPROJ / CV_TN), CV_T_OUT = (DM / CV_TK) * (DM / CV_TN);
constexpr int CV_PER_LAYER = 4 * CV_T_GU + 2 * CV_T_DN + CV_T_IN + CV_T_OUT;
__device__ __forceinline__ void cv_decode(const Params& p, int gt, CvJob& j, int& tk, int& tn) {
    const int l = gt / CV_PER_LAYER; int r = gt - l * CV_PER_LAYER;
    unsigned char* ws = p.ws;
    int tiles_n;
    if (r < 4 * CV_T_GU) { const int w = r / CV_T_GU; r -= w * CV_T_GU; const int f = w >> 1, up = w & 1;
        j.src = p.in[(f ? 25 : 2) + up] + (size_t)l * DM * DFF; j.gain = p.in[f ? 24 : 1] + l * DM; j.dst = (bf16_t*)(ws + WS_WGU + (size_t)(l * 2 + f) * SZ_WGU); j.K = DM; j.N = DFF; j.mode = 1 + up; tiles_n = DFF / CV_TN; }
    else if ((r -= 4 * CV_T_GU) < 2 * CV_T_DN) { const int f = r / CV_T_DN; r -= f * CV_T_DN;
        j.src = p.in[f ? 27 : 4] + (size_t)l * DFF * DM; j.gain = nullptr; j.dst = (bf16_t*)(ws + WS_WDN + (size_t)(l * 2 + f) * SZ_WDN); j.K = DFF; j.N = DM; j.mode = 0; tiles_n = DM / CV_TN; }
    else if ((r -= 2 * CV_T_DN) < CV_T_IN) {
        j.src = p.in[6] + (size_t)l * DM * NPROJ; j.gain = p.in[5] + l * DM; j.dst = (bf16_t*)(ws + WS_WIN + (size_t)l * SZ_WIN); j.K = DM; j.N = NPROJ; j.mode = 0; tiles_n = NPROJ / CV_TN; }
    else { r -= CV_T_IN;
        j.src = p.in[23] + (size_t)l * DM * DM; j.gain = p.in[22] + l * DM; j.dst = (bf16_t*)(ws + WS_WOUT + (size_t)l * SZ_WOUT); j.K = DM; j.N = DM; j.mode = 0; tiles_n = DM / CV_TN; }
    tk = r / tiles_n; tn = r - tk * tiles_n;
}
__device__ __forceinline__ void cv_load(const Params& p, int gt, f32x4 (&v)[8]) {
    CvJob j; int tk, tn; cv_decode(p, gt, j, tk, tn);
    const int tid = threadIdx.x;
#pragma unroll
    for (int it = 0; it < 8; ++it) { const int idx = tid + it * NTHREADS, k = idx >> 6, n4 = idx & 63;
        f32x4 x = __builtin_nontemporal_load((const f32x4*)(j.src + (size_t)(tk * CV_TK + k) * j.N + tn * CV_TN + n4 * 4));
        if (j.gain) x = x * j.gain[tk * CV_TK + k];
        v[it] = x; }
}
__device__ __forceinline__ void phase_convert(const Params& p, LAS unsigned char* lds) {
    LAS float* T = (LAS float*)lds;
    const int tid = threadIdx.x, G = gridDim.x;
    const int total = 2 * CV_PER_LAYER;
    int gt = blockIdx.x;
    f32x4 v[8];
    if (gt < total) cv_load(p, gt, v);
    for (; gt < total; gt += G) {
        __syncthreads();
#pragma unroll
        for (int it = 0; it < 8; ++it) { const int idx = tid + it * NTHREADS, k = idx >> 6, n4 = idx & 63; *(LAS f32x4*)(T + k * CV_LD + n4 * 4) = v[it]; }
        CvJob j; int tk, tn; cv_decode(p, gt, j, tk, tn);
        if (gt + G < total) cv_load(p, gt + G, v);
        __syncthreads();
        const int n = tid >> 1, kc = tid & 1;
        unsigned w[16];
#pragma unroll
        for (int i = 0; i < 16; ++i) w[i] = pk2(T[(kc * 32 + 2 * i) * CV_LD + n], T[(kc * 32 + 2 * i + 1) * CV_LD + n]);
        const int ng = tn * CV_TN + n;
        const int row = j.mode == 0 ? ng : ((ng >> 7) * 256 + (j.mode == 2 ? 128 : 0) + (ng & 127));
        bf16_t* d = j.dst + (size_t)row * j.K + tk * CV_TK + kc * 32;
#pragma unroll
        for (int i = 0; i < 4; ++i) *(u32x4*)(d + 8 * i) = (u32x4){w[4 * i], w[4 * i + 1], w[4 * i + 2], w[4 * i + 3]};
    }
    __syncthreads();
}

template <int KIN, int LDI> __device__ __forceinline__ void filt_layer(const float* __restrict__ w, const float* __restrict__ bias, const float* __restrict__ fr, const LAS float* hin, LAS float* hout) {
    const int tid = threadIdx.x, j = tid & 63, pg = tid >> 6;
    float a[4]; const float bj = bias[j];
#pragma unroll
    for (int i = 0; i < 4; ++i) a[i] = bj;
#pragma unroll 8
    for (int e = 0; e < KIN; ++e) { const float wv = w[e * 64 + j];
#pragma unroll
        for (int i = 0; i < 4; ++i) a[i] += hin[(pg * 4 + i) * LDI + e] * wv; }
    const float f = fr[j];
#pragma unroll
    for (int i = 0; i < 4; ++i) hout[(pg * 4 + i) * 64 + j] = sinf(f * a[i]);
}
__device__ __forceinline__ void phase_filter(const Params& p, LAS unsigned char* lds) {
    LAS float* zs = (LAS float*)lds;
    LAS float* h1 = zs + 32 * 36;
    LAS float* h2 = h1 + 32 * 64;
    LAS float* h3 = h2 + 32 * 64;
    const int tid = threadIdx.x, G = gridDim.x;
    bf16_t* KF = (bf16_t*)(p.ws + WS_KF);
    for (int u = blockIdx.x; u < 256; u += G) {
        const int l = u >> 7, n0 = (u & 127) * 32;
        const float* fr = p.in[15] + l * 64; const float* __restrict__ wo = p.in[16] + (size_t)l * 64 * 1024;
        __syncthreads();
        for (int idx = tid; idx < 32 * 33; idx += NTHREADS) { const int pp = idx / 33, e = idx - pp * 33; const float n = (float)(n0 + pp);
            float val;
            if (e == 0) val = n / 4095.0f;
            else { const int k = (e - 1) & 15; const float band = 1e-4f + (float)k * ((15.0f - 1e-4f) / 15.0f); const float ang = (6.283185307179586f / 4096.0f) * n * band;
                val = (e <= 16) ? cosf(ang) : sinf(ang); }
            zs[pp * 36 + e] = val; }
        __syncthreads();
        filt_layer<33, 36>(p.in[9] + l * 33 * 64, p.in[10] + l * 64, fr, zs, h1);
        __syncthreads();
        filt_layer<64, 64>(p.in[11] + l * 64 * 64, p.in[12] + l * 64, fr, h1, h2);
        __syncthreads();
        filt_layer<64, 64>(p.in[13] + l * 64 * 64, p.in[14] + l * 64, fr, h2, h3);
        __syncthreads();
        float af[32], ab[32];
#pragma unroll
        for (int pp = 0; pp < 32; ++pp) { af[pp] = 0.f; ab[pp] = 0.f; }
        for (int k4 = 0; k4 < 16; ++k4) {
            float wa[4], wb[4];
#pragma unroll
            for (int i = 0; i < 4; ++i) { wa[i] = wo[(k4 * 4 + i) * 1024 + tid]; wb[i] = wo[(k4 * 4 + i) * 1024 + 512 + tid]; }
#pragma unroll
            for (int pp = 0; pp < 32; ++pp) { const f32x4 hv = *(const LAS f32x4*)(h3 + pp * 64 + k4 * 4);
                af[pp] += hv[0] * wa[0] + hv[1] * wa[1] + hv[2] * wa[2] + hv[3] * wa[3];
                ab[pp] += hv[0] * wb[0] + hv[1] * wb[1] + hv[2] * wb[2] + hv[3] * wb[3]; }
        }
        const int c = tid;
        const float dlo = -3.0701134573253945f, dhi = -15.350567286626973f;
        const float delta = fabsf(dlo + (float)c * ((dhi - dlo) / 511.0f));
#pragma unroll
        for (int pp = 0; pp < 32; ++pp) { const float t = (float)(n0 + pp) / 4095.0f; const float win = expf(-t * delta) + 0.05f; af[pp] *= win; ab[pp] *= win; }
        bf16_t* kc = KF + ((size_t)l * 512 + c) * 8192;
#pragma unroll
        for (int i = 0; i < 4; ++i) *(u32x4*)(kc + 4096 + n0 + 8 * i) = (u32x4){pk2(af[8 * i], af[8 * i + 1]), pk2(af[8 * i + 2], af[8 * i + 3]), pk2(af[8 * i + 4], af[8 * i + 5]), pk2(af[8 * i + 6], af[8 * i + 7])};
        if (n0 == 0) kc[0] = 0;
        bf16_t* kb = kc + 4065 - n0;
#define BW(jx) ab[31 - (jx)]
        kb[0] = (bf16_t)(pk2(BW(0), 0.f) & 0xffffu);
        *(unsigned*)(kb + 1) = pk2(BW(1), BW(2));
        *(u32x2*)(kb + 3) = (u32x2){pk2(BW(3), BW(4)), pk2(BW(5), BW(6))};
#pragma unroll
        for (int i = 0; i < 3; ++i) *(u32x4*)(kb + 7 + 8 * i) = (u32x4){pk2(BW(7 + 8 * i), BW(8 + 8 * i)), pk2(BW(9 + 8 * i), BW(10 + 8 * i)), pk2(BW(11 + 8 * i), BW(12 + 8 * i)), pk2(BW(13 + 8 * i), BW(14 + 8 * i))};
        if (n0 != 0) kb[31] = (bf16_t)(pk2(BW(31), 0.f) & 0xffffu);
#undef BW
    }
    __syncthreads();
}

__device__ __forceinline__ void phase_x0(const float* x, bf16_t* xb, unsigned long long* ss) {
    const int lane = threadIdx.x & 63, wave = threadIdx.x >> 6;
    const int gw = blockIdx.x * 8 + wave, nw = gridDim.x * 8;
    for (int i = blockIdx.x * NTHREADS + threadIdx.x; i < 5 * MTOK; i += gridDim.x * NTHREADS) ss[MTOK + i] = 0ull;
    for (int row = gw; row < MTOK; row += nw) {
        const float* xr = x + (size_t)row * DM;
        f32x4 v[8]; float sq = 0.f;
#pragma unroll
        for (int i = 0; i < 8; ++i) v[i] = __builtin_nontemporal_load((const f32x4*)(xr + i * 256 + lane * 4));
#pragma unroll
        for (int i = 0; i < 8; ++i) sq += v[i][0] * v[i][0] + v[i][1] * v[i][1] + v[i][2] * v[i][2] + v[i][3] * v[i][3];
        sq = wave_sum(sq);
        if (lane == 0) ss[row] = (unsigned long long)(sq * 1048576.0f);
        bf16_t* hr = xb + (size_t)row * DM;
#pragma unroll
        for (int i = 0; i < 8; ++i) *(u32x2*)(hr + i * 256 + lane * 4) = (u32x2){pk2(v[i][0], v[i][1]), pk2(v[i][2], v[i][3])};
    }
}

__device__ __forceinline__ void phase_hyprep(const Params& p, int l) {
    const bf16_t* PB = (const bf16_t*)(p.ws + WS_PB); bf16_t* ZVT = (bf16_t*)(p.ws + WS_ZVT);
    const float* sw = p.in[7] + l * 3 * 1536; const float* sb = p.in[8] + l * 1536;
    const int lane = threadIdx.x & 63, wave = threadIdx.x >> 6;
    const int gw = blockIdx.x * 8 + wave, nw = gridDim.x * 8;
    for (int task = gw; task < 4096; task += nw) {
        const int tg = task >> 1, ch = task & 1; const int c = ch * 256 + lane * 4;
        const int tglob = tg * 8, b = tglob >> 12, t0 = tglob & 4095;
        f32x4 w1[3], wv[3];
#pragma unroll
        for (int j = 0; j < 3; ++j) { w1[j] = *(const f32x4*)(sw + j * 1536 + 512 + c); wv[j] = *(const f32x4*)(sw + j * 1536 + 1024 + c); }
        const f32x4 bb1 = *(const f32x4*)(sb + 512 + c), bbv = *(const f32x4*)(sb + 1024 + c);
        f32x4 r1[10], rv[10];
#pragma unroll
        for (int i = 0; i < 10; ++i) { const int t = t0 - 1 + i;
            if (t >= 0 && t < SEQ) { const bf16_t* row = PB + (size_t)(b * SEQ + t) * NPROJ;
                const u32x2 a = *(const u32x2*)(row + 512 + c), d = *(const u32x2*)(row + 1024 + c);
                r1[i] = (f32x4){bflo(a.x), bfhi(a.x), bflo(a.y), bfhi(a.y)}; rv[i] = (f32x4){bflo(d.x), bfhi(d.x), bflo(d.y), bfhi(d.y)}; }
            else { r1[i] = (f32x4){0.f, 0.f, 0.f, 0.f}; rv[i] = r1[i]; } }
        f32x4 zv[8];
#pragma unroll
        for (int i = 0; i < 8; ++i) { const f32x4 x1 = w1[0] * r1[i] + w1[1] * r1[i + 1] + w1[2] * r1[i + 2] + bb1; const f32x4 vv = wv[0] * rv[i] + wv[1] * rv[i + 1] + wv[2] * rv[i + 2] + bbv; zv[i] = x1 * vv; }
#pragma unroll
        for (int e = 0; e < 4; ++e) { const u32x4 w = (u32x4){pk2(zv[0][e], zv[1][e]), pk2(zv[2][e], zv[3][e]), pk2(zv[4][e], zv[5][e]), pk2(zv[6][e], zv[7][e])};
            *(u32x4*)(ZVT + ((size_t)(c + e) * 4 + b) * SEQ + t0) = w; }
    }
}

constexpr int HY_VS = 0, HY_ZS = 66560, HY_TMP = HY_ZS + 4 * 64 * 144;
__device__ __forceinline__ void hyena_conv_unit(LAS unsigned char* lds, const bf16_t* KFc, const bf16_t* ZVc, float* CONVc) {
    const int tid = threadIdx.x, lane = tid & 63, wid = tid >> 6, r = lane & 15, q = lane >> 4;
    const int b = wid >> 1, ib = (wid & 1) * 32;
    __syncthreads();
#pragma unroll
    for (int k = 0; k < 4; ++k) { const int idx = tid + k * NTHREADS; const int bb = idx >> 9, ch = idx & 511;
        const u32x4 v = *(const u32x4*)(ZVc + bb * SEQ + ch * 8);
        *(LAS u32x4*)(lds + HY_ZS + bb * 9216 + (ch >> 3) * 144 + (ch & 7) * 16) = v; }
    f32x4 acc[4][2];
#pragma unroll
    for (int m = 0; m < 4; ++m) { acc[m][0] = (f32x4){0.f, 0.f, 0.f, 0.f}; acc[m][1] = acc[m][0]; }
    LAS unsigned short* TMP = (LAS unsigned short*)(lds + HY_TMP);
    for (int hf = 0; hf < 2; ++hf) {
        const int xlo = hf ? -56 : -4088, cnt = hf ? 4152 : 4088;
        __syncthreads();
        for (int e = tid; e < cnt + 7; e += NTHREADS) TMP[e] = KFc[4096 + xlo - 7 + e];
        __syncthreads();
        for (int e = tid; e < cnt; e += NTHREADS) {
            unsigned w[4];
#pragma unroll
            for (int i = 0; i < 4; ++i) w[i] = (unsigned)TMP[e + 7 - 2 * i] | ((unsigned)TMP[e + 6 - 2 * i] << 16);
            *(LAS u32x4*)(lds + HY_VS + e * 16) = (u32x4){w[0], w[1], w[2], w[3]}; }
        __syncthreads();
        const int dlo = hf ? 0 : -63, dhi = hf ? 63 : -1;
        for (int d = dlo; d <= dhi; ++d) {
            if (ib + 31 - d < 0 || ib - d > 63) continue;
            const int base = 64 * d + r - 8 * q - xlo;
            bf16x8 Af[6];
#pragma unroll
            for (int bi = 0; bi < 6; ++bi) Af[bi] = *(const LAS bf16x8*)(lds + HY_VS + (base - 32 + 16 * bi) * 16);
#pragma unroll
            for (int nt = 0; nt < 2; ++nt) {
                const int i0 = ib + 16 * nt;
                if (i0 + 15 - d < 0 || i0 - d > 63) continue;
                const int j = i0 + r - d; const bool valid = (unsigned)j < 64u; const int jc = valid ? j : 0;
                bf16x8 Bf[2];
#pragma unroll
                for (int kk = 0; kk < 2; ++kk) { bf16x8 t = *(const LAS bf16x8*)(lds + HY_ZS + b * 9216 + jc * 144 + kk * 64 + q * 16);
                    if (!valid) t = (bf16x8){0, 0, 0, 0, 0, 0, 0, 0};
                    Bf[kk] = t; }
#pragma unroll
                for (int kk = 0; kk < 2; ++kk)
#pragma unroll
                    for (int m = 0; m < 4; ++m) acc[m][nt] = __builtin_amdgcn_mfma_f32_16x16x32_bf16(Af[m - 2 * kk + 2], Bf[kk], acc[m][nt], 0, 0, 0);
            }
        }
    }
#pragma unroll
    for (int nt = 0; nt < 2; ++nt)
#pragma unroll
        for (int m = 0; m < 4; ++m) *(f32x4*)(CONVc + b * SEQ + 64 * (ib + 16 * nt + r) + 16 * m + 4 * q) = acc[m][nt];
}

constexpr int AT_KS = 0, AT_KS_LD = 144, AT_VT = 384 * 144, AT_VT_LD = 784;
__device__ __forceinline__ void attn_unit(LAS unsigned char* lds, const bf16_t* PB, bf16_t* YAT, int u, const float* qg, const float* kg, const float* sink) {
    const int tid = threadIdx.x, lane = tid & 63, wid = tid >> 6, r = lane & 15, q = lane >> 4;
    const int b = u >> 7, nb = (u & 127) >> 2, kvh = u & 3;
    __syncthreads();
    u32x4 kraw[6], vraw[6];
#pragma unroll
    for (int k = 0; k < 6; ++k) { const int idx = tid + k * NTHREADS; const int key = idx >> 3, ch = idx & 7; const int kpos = 128 * (nb - 1) + key;
        const bool inr = kpos >= 0 && kpos < SEQ;
        const bf16_t* src = PB + (size_t)(b * SEQ + (inr ? kpos : 0)) * NPROJ + kvh * 64 + ch * 8;
        kraw[k] = *(const u32x4*)(src + 4096); vraw[k] = *(const u32x4*)(src + 4352); }
    const int g = wid >> 1, h = kvh * 4 + g;
    const bf16_t* qsrc = PB + (size_t)(b * SEQ + 128 * nb + (wid & 1) * 64 + r) * NPROJ + 3072 + h * 64 + q * 8;
    u32x4 qn0 = *(const u32x4*)(qsrc), qn1 = *(const u32x4*)(qsrc + 32);
#pragma unroll
    for (int k = 0; k < 6; ++k) { const int idx = tid + k * NTHREADS; const int key = idx >> 3, ch = idx & 7; const int kpos = 128 * (nb - 1) + key;
        const bool inr = kpos >= 0 && kpos < SEQ;
        u32x4 kv = kraw[k], vv = vraw[k];
        if (!inr) { kv = (u32x4){0u, 0u, 0u, 0u}; vv = kv; }
        float kf[8] = {bflo(kv.x), bfhi(kv.x), bflo(kv.y), bfhi(kv.y), bflo(kv.z), bfhi(kv.z), bflo(kv.w), bfhi(kv.w)};
        float ss = 0.f;
#pragma unroll
        for (int i = 0; i < 8; ++i) ss += kf[i] * kf[i];
        ss += __shfl_xor(ss, 1); ss += __shfl_xor(ss, 2); ss += __shfl_xor(ss, 4);
        const float rs = rsqrtf(ss * (1.0f / 64.0f) + EPS);
        const f32x4 g0 = *(const f32x4*)(kg + ch * 8), g1 = *(const f32x4*)(kg + ch * 8 + 4);
        const u32x4 ko = (u32x4){pk2(kf[0] * rs * g0[0], kf[1] * rs * g0[1]), pk2(kf[2] * rs * g0[2], kf[3] * rs * g0[3]), pk2(kf[4] * rs * g1[0], kf[5] * rs * g1[1]), pk2(kf[6] * rs * g1[2], kf[7] * rs * g1[3])};
        *(LAS u32x4*)(lds + AT_KS + key * AT_KS_LD + ch * 16) = ko;
        const unsigned vw[4] = {vv.x, vv.y, vv.z, vv.w};
#pragma unroll
        for (int i = 0; i < 8; ++i) *(LAS unsigned short*)(lds + AT_VT + (ch * 8 + i) * AT_VT_LD + key * 2) = (unsigned short)((i & 1) ? (vw[i >> 1] >> 16) : (vw[i >> 1] & 0xffffu));
    }
    __syncthreads();
    const float slope = exp2f(-0.5f * (float)(h + 1)), snk = sink[h];
    for (int si = 0; si < 4; ++si) {
        const int q0 = ((wid & 1) * 4 + si) * 16; const int qpos = 128 * nb + q0 + r;
        const u32x4 qc0 = qn0, qc1 = qn1;
        if (si < 3) { qn0 = *(const u32x4*)(qsrc + (size_t)(si + 1) * 16 * NPROJ); qn1 = *(const u32x4*)(qsrc + (size_t)(si + 1) * 16 * NPROJ + 32); }
        bf16x8 Qf[2];
        {
            const u32x4 a0 = qc0, a1 = qc1;
            float f0[8] = {bflo(a0.x), bfhi(a0.x), bflo(a0.y), bfhi(a0.y), bflo(a0.z), bfhi(a0.z), bflo(a0.w), bfhi(a0.w)};
            float f1[8] = {bflo(a1.x), bfhi(a1.x), bflo(a1.y), bfhi(a1.y), bflo(a1.z), bfhi(a1.z), bflo(a1.w), bfhi(a1.w)};
            float ss = 0.f;
#pragma unroll
            for (int i = 0; i < 8; ++i) ss += f0[i] * f0[i] + f1[i] * f1[i];
            ss += __shfl_xor(ss, 16); ss += __shfl_xor(ss, 32);
            const float rs = rsqrtf(ss * (1.0f / 64.0f) + EPS) * 0.125f;
            const f32x4 ga = *(const f32x4*)(qg + q * 8), gb = *(const f32x4*)(qg + q * 8 + 4), gc = *(const f32x4*)(qg + 32 + q * 8), gd = *(const f32x4*)(qg + 32 + q * 8 + 4);
            const u32x4 w0 = (u32x4){pk2(f0[0] * rs * ga[0], f0[1] * rs * ga[1]), pk2(f0[2] * rs * ga[2], f0[3] * rs * ga[3]), pk2(f0[4] * rs * gb[0], f0[5] * rs * gb[1]), pk2(f0[6] * rs * gb[2], f0[7] * rs * gb[3])};
            const u32x4 w1 = (u32x4){pk2(f1[0] * rs * gc[0], f1[1] * rs * gc[1]), pk2(f1[2] * rs * gc[2], f1[3] * rs * gc[3]), pk2(f1[4] * rs * gd[0], f1[5] * rs * gd[1]), pk2(f1[6] * rs * gd[2], f1[7] * rs * gd[3])};
            Qf[0] = __builtin_bit_cast(bf16x8, w0); Qf[1] = __builtin_bit_cast(bf16x8, w1);
        }
        const int kt0 = q0 >> 4;
        f32x4 S[17];
#pragma unroll
        for (int tt = 0; tt < 17; ++tt) {
            const LAS unsigned char* kp = lds + AT_KS + (16 * (kt0 + tt) + r) * AT_KS_LD + q * 16;
            const bf16x8 k0 = *(const LAS bf16x8*)kp, k1 = *(const LAS bf16x8*)(kp + 64);
            f32x4 s = __builtin_amdgcn_mfma_f32_16x16x32_bf16(k0, Qf[0], (f32x4){0.f, 0.f, 0.f, 0.f}, 0, 0, 0);
            S[tt] = __builtin_amdgcn_mfma_f32_16x16x32_bf16(k1, Qf[1], s, 0, 0, 0);
        }
        float mx = snk;
#pragma unroll
        for (int tt = 0; tt < 17; ++tt)
#pragma unroll
            for (int jj = 0; jj < 4; ++jj) { const int kl = 16 * (kt0 + tt) + 4 * q + jj; const int kpos = 128 * (nb - 1) + kl;
                int dist = 128 + q0 + r - kl; dist = dist < 0 ? -dist : dist;
                const bool valid = dist <= 128 && kpos >= 0 && kpos < SEQ;
                const float lg = valid ? S[tt][jj] - slope * (float)dist : -1e30f;
                S[tt][jj] = lg; mx = fmaxf(mx, lg); }
        mx = fmaxf(mx, __shfl_xor(mx, 16)); mx = fmaxf(mx, __shfl_xor(mx, 32));
        float sum = 0.f;
#pragma unroll
        for (int tt = 0; tt < 17; ++tt)
#pragma unroll
            for (int jj = 0; jj < 4; ++jj) { const float pe = __expf(S[tt][jj] - mx); S[tt][jj] = pe; sum += pe; }
        sum += __shfl_xor(sum, 16); sum += __shfl_xor(sum, 32);
        const float inv = 1.0f / (sum + __expf(snk - mx));
        f32x4 O[4];
#pragma unroll
        for (int dt = 0; dt < 4; ++dt) O[dt] = (f32x4){0.f, 0.f, 0.f, 0.f};
#pragma unroll
        for (int pr = 0; pr < 9; ++pr) {
            const int t0 = 2 * pr, t1 = 2 * pr + 1;
            u32x4 pw; pw.x = pk2(S[t0][0], S[t0][1]); pw.y = pk2(S[t0][2], S[t0][3]);
            if (t1 < 17) { pw.z = pk2(S[t1 < 17 ? t1 : 16][0], S[t1 < 17 ? t1 : 16][1]); pw.w = pk2(S[t1 < 17 ? t1 : 16][2], S[t1 < 17 ? t1 : 16][3]); } else { pw.z = 0u; pw.w = 0u; }
            const bf16x8 Pf = __builtin_bit_cast(bf16x8, pw);
#pragma unroll
            for (int dt = 0; dt < 4; ++dt) {
                const LAS unsigned char* vp = lds + AT_VT + (16 * dt + r) * AT_VT_LD + (16 * (kt0 + t0) + 4 * q) * 2;
                const u32x2 lo = *(const LAS u32x2*)vp; u32x2 hi = (u32x2){0u, 0u};
                if (t1 < 17) hi = *(const LAS u32x2*)(vp + 32);
                const bf16x8 Vf = __builtin_bit_cast(bf16x8, (u32x4){lo.x, lo.y, hi.x, hi.y});
                O[dt] = __builtin_amdgcn_mfma_f32_16x16x32_bf16(Vf, Pf, O[dt], 0, 0, 0);
            }
        }
        bf16_t* dst = YAT + (size_t)(b * SEQ + qpos) * 1024 + h * 64 + 4 * q;
#pragma unroll
        for (int dt = 0; dt < 4; ++dt) *(u32x2*)(dst + 16 * dt) = (u32x2){pk2(O[dt][0] * inv, O[dt][1] * inv), pk2(O[dt][2] * inv, O[dt][3] * inv)};
    }
}

__device__ __forceinline__ void phase_mix(const Params& p, int l, LAS unsigned char* lds) {
    const int G = gridDim.x;
    const bf16_t* PB = (const bf16_t*)(p.ws + WS_PB);
    for (int c = blockIdx.x; c < 512; c += G)
        hyena_conv_unit(lds, (const bf16_t*)(p.ws + WS_KF) + ((size_t)l * 512 + c) * 8192, (const bf16_t*)(p.ws + WS_ZVT) + (size_t)c * 4 * SEQ, (float*)(p.ws + WS_CONVT) + (size_t)c * 4 * SEQ);
    for (int u = blockIdx.x; u < 512; u += G)
        attn_unit(lds, PB, (bf16_t*)(p.ws + WS_YAT), u, p.in[19] + l * 64, p.in[20] + l * 64, p.in[21] + l * 16);
    __syncthreads();
}

constexpr int PO_LD = 516;
__device__ __forceinline__ void ld8(const bf16_t* p, bool ok, float (&f)[8]) {
    u32x4 a = (u32x4){0u, 0u, 0u, 0u}; if (ok) a = *(const u32x4*)p;
    f[0] = bflo(a.x); f[1] = bfhi(a.x); f[2] = bflo(a.y); f[3] = bfhi(a.y); f[4] = bflo(a.z); f[5] = bfhi(a.z); f[6] = bflo(a.w); f[7] = bfhi(a.w);
}
__device__ __forceinline__ void phase_post(const Params& p, int l, LAS unsigned char* lds) {
    LAS float* Cs = (LAS float*)lds;
    const int tid = threadIdx.x, lane = tid & 63, wid = tid >> 6, G = gridDim.x;
    const bf16_t* PB = (const bf16_t*)(p.ws + WS_PB); const float* CONVT = (const float*)(p.ws + WS_CONVT); const bf16_t* YAT = (const bf16_t*)(p.ws + WS_YAT);
    bf16_t* YB = (bf16_t*)(p.ws + WS_YB);
    const float* sw = p.in[7] + l * 3 * 1536; const float* sb = p.in[8] + l * 1536; const float* bd = p.in[17] + l * 512; const float* cw = p.in[18] + l * 3 * 512;
    const int c = lane * 8;
    for (int u = blockIdx.x; u < MTOK / 32; u += G) {
        const int tg0 = u * 32, b = tg0 >> 12, tt = tg0 & 4095;
        __syncthreads();
#pragma unroll
        for (int k = 0; k < 8; ++k) { const int idx = tid + k * NTHREADS; const int cc = idx >> 3, ch = idx & 7;
            const f32x4 v = *(const f32x4*)(CONVT + ((size_t)cc * 4 + b) * SEQ + tt + ch * 4);
#pragma unroll
            for (int e = 0; e < 4; ++e) Cs[(ch * 4 + e) * PO_LD + cc] = v[e]; }
        __syncthreads();
        for (int ti = 0; ti < 4; ++ti) {
            const int tl = wid * 4 + ti, t = tt + tl;
            const bf16_t* row = PB + (size_t)(b * SEQ + t) * NPROJ;
            const bool okm = t > 0, okp = t < SEQ - 1;
            float yv[8];
            {
                float um[3][8];
#pragma unroll
                for (int part = 0; part < 3; ++part) {
                    float pm[8], pc[8], pp[8];
                    ld8(row - NPROJ + part * 512 + c, okm, pm); ld8(row + part * 512 + c, true, pc); ld8(row + NPROJ + part * 512 + c, okp, pp);
#pragma unroll
                    for (int hh = 0; hh < 2; ++hh) { const f32x4 w0 = *(const f32x4*)(sw + part * 512 + c + hh * 4), w1 = *(const f32x4*)(sw + 1536 + part * 512 + c + hh * 4), w2 = *(const f32x4*)(sw + 3072 + part * 512 + c + hh * 4), bb = *(const f32x4*)(sb + part * 512 + c + hh * 4);
#pragma unroll
                        for (int e = 0; e < 4; ++e) um[part][hh * 4 + e] = w0[e] * pm[hh * 4 + e] + w1[e] * pc[hh * 4 + e] + w2[e] * pp[hh * 4 + e] + bb[e]; }
                }
                const f32x4 c0 = *(const LAS f32x4*)(Cs + tl * PO_LD + c), c1 = *(const LAS f32x4*)(Cs + tl * PO_LD + c + 4);
                const f32x4 d0 = *(const f32x4*)(bd + c), d1 = *(const f32x4*)(bd + c + 4);
                float ss = 0.f;
#pragma unroll
                for (int e = 0; e < 8; ++e) { const float zv = um[2][e] * um[1][e]; const float cv = e < 4 ? c0[e] : c1[e - 4]; const float dd = e < 4 ? d0[e] : d1[e - 4];
                    yv[e] = um[0][e] * (cv + zv * dd); ss += yv[e] * yv[e]; }
                ss = wave_sum(ss);
                const float rs = rsqrtf(ss * (1.0f / 512.0f) + EPS);
                *(u32x4*)(YB + (size_t)(b * SEQ + t) * DM + c) = (u32x4){pk2(yv[0] * rs, yv[1] * rs), pk2(yv[2] * rs, yv[3] * rs), pk2(yv[4] * rs, yv[5] * rs), pk2(yv[6] * rs, yv[7] * rs)};
            }
            {
                float gbv[8], cm[8], hm[8], cc0[8], hc[8], cp[8], hp[8];
                ld8(row + 1536 + c, true, gbv);
                ld8(row - NPROJ + 2048 + c, okm, cm); ld8(row - NPROJ + 2560 + c, okm, hm);
                ld8(row + 2048 + c, true, cc0); ld8(row + 2560 + c, true, hc);
                ld8(row + NPROJ + 2048 + c, okp, cp); ld8(row + NPROJ + 2560 + c, okp, hp);
                float ss = 0.f;
#pragma unroll
                for (int hh = 0; hh < 2; ++hh) { const f32x4 w0 = *(const f32x4*)(cw + c + hh * 4), w1 = *(const f32x4*)(cw + 512 + c + hh * 4), w2 = *(const f32x4*)(cw + 1024 + c + hh * 4);
#pragma unroll
                    for (int e = 0; e < 4; ++e) { const int k = hh * 4 + e; const float y = gbv[k] * (w0[e] * cm[k] * hm[k] + w1[e] * cc0[k] * hc[k] + w2[e] * cp[k] * hp[k]); yv[k] = y; ss += y * y; } }
                ss = wave_sum(ss);
                const float rs = rsqrtf(ss * (1.0f / 512.0f) + EPS);
                *(u32x4*)(YB + (size_t)(b * SEQ + t) * DM + 512 + c) = (u32x4){pk2(yv[0] * rs, yv[1] * rs), pk2(yv[2] * rs, yv[3] * rs), pk2(yv[4] * rs, yv[5] * rs), pk2(yv[6] * rs, yv[7] * rs)};
            }
            {
                float a0[8], a1[8];
                const bf16_t* ya = YAT + (size_t)(b * SEQ + t) * 1024;
                ld8(ya + c, true, a0); ld8(ya + 512 + c, true, a1);
                float ss = 0.f;
#pragma unroll
                for (int e = 0; e < 8; ++e) ss += a0[e] * a0[e] + a1[e] * a1[e];
                ss = wave_sum(ss);
                const float rs = rsqrtf(ss * (1.0f / 1024.0f) + EPS);
                bf16_t* yo = YB + (size_t)(b * SEQ + t) * DM + 1024;
                *(u32x4*)(yo + c) = (u32x4){pk2(a0[0] * rs, a0[1] * rs), pk2(a0[2] * rs, a0[3] * rs), pk2(a0[4] * rs, a0[5] * rs), pk2(a0[6] * rs, a0[7] * rs)};
                *(u32x4*)(yo + 512 + c) = (u32x4){pk2(a1[0] * rs, a1[1] * rs), pk2(a1[2] * rs, a1[3] * rs), pk2(a1[4] * rs, a1[5] * rs), pk2(a1[6] * rs, a1[7] * rs)};
            }
        }
    }
    __syncthreads();
}

#define XB_TMO      128
#define XB_XCNT(j)  (256  + 64 * (j))
#define XB_XSUB(j)  (1280 + 64 * (j))
#define XB_XGEN(j)  (2304 + 64 * (j))
#define XB_TOP      3328
#define XB_TOPGEN   3392
#define XCD_BAR_WORDS 3456
#define XB_SPIN_CAP (1u << 18)

__device__ __forceinline__ unsigned xb_ld(unsigned* p)              { return __hip_atomic_load(p, __ATOMIC_RELAXED, __HIP_MEMORY_SCOPE_AGENT); }
__device__ __forceinline__ unsigned xb_add(unsigned* p, unsigned v) { return __hip_atomic_fetch_add(p, v, __ATOMIC_RELAXED, __HIP_MEMORY_SCOPE_AGENT); }
__device__ __forceinline__ unsigned xb_xcc_id() { return (unsigned)__builtin_amdgcn_s_getreg((3 << 11) | 20) & 0xFu; }
#define XB_SPIN(cond, bar) do { unsigned _sp = 0; while (cond) { __builtin_amdgcn_s_sleep(1); \
    if ((++_sp & 255u) == 0u) { if (xb_ld(&(bar)[XB_TMO])) break; if (_sp > XB_SPIN_CAP) { atomicAdd(&(bar)[XB_TMO], 1u); break; } } } } while (0)

struct XcdBarrier {
    unsigned* bar; unsigned x;
    volatile LAS unsigned* st;
};

__device__ __forceinline__ XcdBarrier xcd_barrier_post(unsigned* bar, volatile LAS unsigned* st) {
    XcdBarrier b; b.bar = bar; b.x = xb_xcc_id(); b.st = st;
    if (threadIdx.x == 0) (void)xb_add(&bar[XB_XCNT(b.x)], 1u);
    return b;
}
__device__ __forceinline__ void xcd_barrier_complete(unsigned* bar, unsigned x, unsigned& nloc, unsigned& nx) {
    const unsigned G = gridDim.x * gridDim.y * gridDim.z;
    unsigned sum, cnt, mine, sp = 0u;
    for (;;) {
        sum = 0u; cnt = 0u; mine = 0u;
#pragma unroll
        for (unsigned j = 0; j < 16; ++j) { const unsigned c = xb_ld(&bar[XB_XCNT(j)]); sum += c; cnt += (c > 0u) ? 1u : 0u; mine = (j == x) ? c : mine; }
        if (sum == G) break;
        __builtin_amdgcn_s_sleep(1);
        if ((++sp & 255u) == 0u) { if (xb_ld(&bar[XB_TMO])) break; if (sp > XB_SPIN_CAP) { atomicAdd(&bar[XB_TMO], 1u); break; } }
    }
    nloc = mine > 0u ? mine : 1u; nx = cnt > 0u ? cnt : 1u;
}

__device__ __forceinline__ void xcd_barrier(const XcdBarrier& b) {
    asm volatile("s_waitcnt vmcnt(0)" ::: "memory");
    __syncthreads();
    if (threadIdx.x == 0) {
        unsigned* bar = b.bar;
        __builtin_amdgcn_s_waitcnt(0);
        unsigned nloc = b.st[0], nx = b.st[1];
        if (nloc == 0u) { xcd_barrier_complete(bar, b.x, nloc, nx); b.st[0] = nloc; b.st[1] = nx; }
        const unsigned old = xb_add(&bar[XB_XSUB(b.x)], 1u);
        const unsigned gen = old / nloc;
        if (old + 1u == (gen + 1u) * nloc) {
            __builtin_amdgcn_fence(__ATOMIC_RELEASE, "agent");
            asm volatile("s_waitcnt vmcnt(0)" ::: "memory");
            const unsigned og = xb_add(&bar[XB_TOP], 1u);
            const unsigned tg = og / nx;
            if (og + 1u == (tg + 1u) * nx) xb_add(&bar[XB_TOPGEN], 1u);
            else XB_SPIN(xb_ld(&bar[XB_TOPGEN]) == tg, bar);
            __builtin_amdgcn_fence(__ATOMIC_ACQUIRE, "agent");
            xb_add(&bar[XB_XGEN(b.x)], 1u);
            asm volatile("s_waitcnt vmcnt(0)" ::: "memory");
        } else {
            XB_SPIN(xb_ld(&bar[XB_XGEN(b.x)]) == gen, bar);
            __builtin_amdgcn_fence(__ATOMIC_ACQUIRE, "agent");
            asm volatile("s_waitcnt vmcnt(0)" ::: "memory");
        }
    }
    __syncthreads();
}


template <class Epi> __device__ __forceinline__ void run_gemm(LAS unsigned char* lds, const bf16_t* A, const bf16_t* Bt, int N, int K, const Epi& E) {
    pg8::Gemm g{A, Bt, MTOK, N, K}; pg8::StaticOrder S; S.init(MTOK, N, (int)gridDim.x, (int)blockIdx.x);
    pg8::gemm_phase<Epi, pg8::StaticOrder, false>(lds, g, S, E, nullptr);
}

constexpr int N_PHASES = 19;
#define IN(k) (lo <= (k) && (k) < hi)
#define SEAM(k) do { if (IN(k) && IN((k) + 1)) { if (lo < 0) grid.sync(); else xcd_barrier(bar); } } while (0)
template <int L> __device__ __forceinline__ void layer_fwd(const Params& p, LAS unsigned char* lds, cg::grid_group& grid, const XcdBarrier& bar, const int lo, const int hi) {
    unsigned char* ws = p.ws;
    bf16_t* XB = (bf16_t*)(ws + WS_HB); bf16_t* ACT = (bf16_t*)(ws + WS_ACT); bf16_t* PB = (bf16_t*)(ws + WS_PB); bf16_t* YB = (bf16_t*)(ws + WS_YB);
    unsigned long long* SS = (unsigned long long*)(ws + WS_SS) + (size_t)(3 * L) * MTOK;
    constexpr int P0 = 1 + 9 * L;
    if (IN(P0 + 0)) { pg8::EpiGU E{ACT, DFF, SS}; run_gemm(lds, XB, (const bf16_t*)(ws + WS_WGU + (size_t)(L * 2 + 0) * SZ_WGU), 2 * DFF, DM, E); } SEAM(P0 + 0);
    if (IN(P0 + 1)) { pg8::EpiResB E{XB, nullptr, DM, 0.5f, SS + MTOK}; run_gemm(lds, ACT, (const bf16_t*)(ws + WS_WDN + (size_t)(L * 2 + 0) * SZ_WDN), DM, DFF, E); } SEAM(P0 + 1);
    if (IN(P0 + 2)) { pg8::EpiB16 E{PB, NPROJ, SS + MTOK}; run_gemm(lds, XB, (const bf16_t*)(ws + WS_WIN + (size_t)L * SZ_WIN), NPROJ, DM, E); } SEAM(P0 + 2);
    if (IN(P0 + 3)) { phase_hyprep(p, L); } SEAM(P0 + 3);
    if (IN(P0 + 4)) { phase_mix(p, L, lds); } SEAM(P0 + 4);
    if (IN(P0 + 5)) { phase_post(p, L, lds); } SEAM(P0 + 5);
    if (IN(P0 + 6)) { pg8::EpiResB E{XB, nullptr, DM, 1.0f, SS + 2 * MTOK}; run_gemm(lds, YB, (const bf16_t*)(ws + WS_WOUT + (size_t)L * SZ_WOUT), DM, DM, E); } SEAM(P0 + 6);
    if (IN(P0 + 7)) { pg8::EpiGU E{ACT, DFF, SS + 2 * MTOK}; run_gemm(lds, XB, (const bf16_t*)(ws + WS_WGU + (size_t)(L * 2 + 1) * SZ_WGU), 2 * DFF, DM, E); } SEAM(P0 + 7);
    if (IN(P0 + 8)) { pg8::EpiResB E{XB, L == 1 ? p.out : nullptr, DM, 0.5f, L == 1 ? nullptr : SS + 3 * MTOK}; run_gemm(lds, ACT, (const bf16_t*)(ws + WS_WDN + (size_t)(L * 2 + 1) * SZ_WDN), DM, DFF, E); }
    if (L == 0) SEAM(P0 + 8);
}
__global__ void __launch_bounds__(NTHREADS, 2) mega_fwd(Params p) {
    extern __shared__ __attribute__((aligned(16))) unsigned char shm[];
    LAS unsigned char* lds = (LAS unsigned char*)shm;
    cg::grid_group grid = cg::this_grid();
    const int lo = p.ph_lo, hi = p.ph_hi;
    if (threadIdx.x < 4) ((LAS unsigned*)(lds + BAR_LDS_OFF))[threadIdx.x] = 0u;
    __syncthreads();
    const XcdBarrier bar = xcd_barrier_post((unsigned*)(p.ws + WS_BAR), (volatile LAS unsigned*)(lds + BAR_LDS_OFF));
    if (IN(0)) { phase_x0(p.in[0], (bf16_t*)(p.ws + WS_HB), (unsigned long long*)(p.ws + WS_SS)); phase_filter(p, lds); phase_convert(p, lds); } SEAM(0);
    layer_fwd<0>(p, lds, grid, bar, lo, hi);
    layer_fwd<1>(p, lds, grid, bar, lo, hi);
}

extern "C" void kernel_launch(void* const* d_in, const int* in_sizes, int n_in, void* d_out, int out_size, void* d_ws, size_t ws_size, hipStream_t stream) {
    static int grid = 0;
    if (grid == 0) {
        if (n_in != 28 || in_sizes[0] != MTOK * DM || out_size != MTOK * DM || ws_size < WS_END) { fprintf(stderr, "kernel_launch: unexpected shapes / workspace (n_in %d, ws %zu < %zu)\n", n_in, ws_size, (size_t)WS_END); grid = -1; return; }
        int dev = 0, cus = 0, per_cu = 0;
        hipGetDevice(&dev); hipDeviceGetAttribute(&cus, hipDeviceAttributeMultiprocessorCount, dev);
        if (hipFuncSetAttribute((const void*)mega_fwd, hipFuncAttributeMaxDynamicSharedMemorySize, LDS_BYTES) != hipSuccess) { fprintf(stderr, "kernel_launch: hipFuncSetAttribute failed\n"); grid = -1; return; }
        if (hipOccupancyMaxActiveBlocksPerMultiprocessor(&per_cu, (const void*)mega_fwd, NTHREADS, LDS_BYTES) != hipSuccess || per_cu < 1) { fprintf(stderr, "kernel_launch: occupancy query gave %d\n", per_cu); per_cu = 1; }
        (void)hipGetLastError();
        grid = cus * per_cu;
    }
    if (grid < 0) return;
    Params p{};
    for (int i = 0; i < 28; ++i) p.in[i] = (const float*)d_in[i];
    p.out = (float*)d_out; p.ws = (unsigned char*)d_ws;
    (void)hipMemsetAsync((unsigned char*)d_ws + WS_BAR, 0, 16384, stream);
#if defined(MK_PER_PHASE)
    for (int ph = 0; ph < N_PHASES; ++ph) { p.ph_lo = ph; p.ph_hi = ph + 1; hipLaunchKernelGGL(mega_fwd, dim3(grid), dim3(NTHREADS), LDS_BYTES, stream, p); }
#else
    p.ph_lo = 0; p.ph_hi = N_PHASES;
    void* args[] = {&p};
    hipError_t e = hipLaunchCooperativeKernel((const void*)mega_fwd, dim3(grid), dim3(NTHREADS), args, LDS_BYTES, stream);
    if (e != hipSuccess) fprintf(stderr, "cooperative launch failed: %s (grid %d)\n", hipGetErrorString(e), grid);
#endif
}
```

```cpp
#include <hip/hip_runtime.h>
#include <hip/hip_cooperative_groups.h>
#include <cstdio>
namespace cg = cooperative_groups;
#include <hip/hip_runtime.h>
namespace pg8 {
#define PG8_LAS __attribute__((address_space(3)))
typedef unsigned short bf16_t;
typedef short bf16x8 __attribute__((ext_vector_type(8)));
typedef float f32x4 __attribute__((ext_vector_type(4)));
typedef unsigned u32x4 __attribute__((ext_vector_type(4)));
constexpr int BM = 256, BK = 64, HALF = 128, HTB = HALF * BK * 2  , STAGE_BYTES = 8 * HTB, NXCD = 8, WGM = 8;

__host__ __device__ __forceinline__ int lds_byte(int r, int c) { const int st = (r >> 4) * 2 + (c >> 5), rr = r & 15, cc = c & 31, ob = rr * 64 + cc * 2; return st * 1024 + (ob ^ (((ob >> 9) & 1) << 5)); }
__host__ __device__ __forceinline__ void stage_rc(int b, int& R, int& C) { const int st = b / 1024, sb = b % 1024, swz = sb ^ (((sb >> 9) & 1) << 5); R = (st >> 1) * 16 + swz / 64; C = (st & 1) * 32 + (swz % 64) / 2; }
__host__ __device__ __forceinline__ int perm32(int rho) { const int n = rho >> 4, i = rho & 15; return 8 * (i >> 2) + 4 * n + (i & 3); }

struct Unit { int pm, pn; };
struct Gemm { const bf16_t* A; const bf16_t* Bt; int M, N, K; };

struct StaticOrder {
    int nM, nN, nwg, G, c;
    __host__ __device__ void init(int M, int N, int G_, int c_) { nM = M / BM; nN = N / BM; nwg = nM * nN; G = G_; c = c_; }
    __host__ __device__ bool next(int i, Unit& u) const {
        const long L = (long)i * G + c; if (L >= nwg) return false;
        int wgid = (int)L; { const int q = nwg / NXCD, r = nwg % NXCD, xcd = wgid % NXCD, off = wgid / NXCD; wgid = (xcd < r ? xcd * (q + 1) : r * (q + 1) + (xcd - r) * q) + off; }
        const int nig = WGM * nN, gid = wgid / nig, fm = gid * WGM, gsz = (nM - fm) < WGM ? (nM - fm) : WGM;
        u.pm = fm + ((wgid % nig) % gsz); u.pn = (wgid % nig) / gsz; return true;
    }
    __device__ __forceinline__ void a_ready(const Unit&) const {}
    __device__ __forceinline__ void done(const Unit&) const {}
};
__device__ __forceinline__ unsigned cvt_pk_bf16(float lo, float hi) { unsigned r; asm volatile("v_cvt_pk_bf16_f32 %0, %1, %2" : "=v"(r) : "v"(lo), "v"(hi)); return r; }

__device__ __forceinline__ void row_rstd(const unsigned long long* ss, int row0, float (&rs)[2][4]) {
#pragma unroll
    for (int ai = 0; ai < 2; ++ai)
#pragma unroll
        for (int m = 0; m < 4; ++m) rs[ai][m] = ss ? __builtin_amdgcn_rsqf((float)ss[row0 + ai * HALF + m * 16] * (1.0f / (2048.0f * 1048576.0f)) + 1e-6f) : 1.0f;
}
struct EpiB16 {
    static constexpr bool PERM = true, AFTER_DRAIN = false;
    bf16_t* O; int ldc; const unsigned long long* ss;
    __device__ __forceinline__ void operator()(const f32x4 (&acc)[2][2][4][2], const Unit& u, int wr, int wc, int fr, int fq) const {
        const int row0 = u.pm * BM + wr * 64 + fr, col0 = u.pn * BM + wc * 32 + 8 * fq;
        float rs[2][4]; row_rstd(ss, row0, rs);
#pragma unroll
        for (int ai = 0; ai < 2; ++ai)
#pragma unroll
            for (int m = 0; m < 4; ++m) { bf16_t* rowp = O + (size_t)(row0 + ai * HALF + m * 16) * ldc + col0;
#pragma unroll
                for (int bj = 0; bj < 2; ++bj) { const f32x4 v0 = acc[ai][bj][m][0] * rs[ai][m], v1 = acc[ai][bj][m][1] * rs[ai][m];
                    u32x4 w; w.x = cvt_pk_bf16(v0[0], v0[1]); w.y = cvt_pk_bf16(v0[2], v0[3]); w.z = cvt_pk_bf16(v1[0], v1[1]); w.w = cvt_pk_bf16(v1[2], v1[3]);
                    *(u32x4*)(rowp + bj * HALF) = w; } }
    }
};
__device__ __forceinline__ float silu_mul(float g, float u) { return g * u * __builtin_amdgcn_rcpf(1.0f + __builtin_amdgcn_exp2f(-1.44269504089f * g)); }
struct EpiGU {
    static constexpr bool PERM = true, AFTER_DRAIN = false;
    bf16_t* O; int ldc; const unsigned long long* ss;
    __device__ __forceinline__ void operator()(const f32x4 (&acc)[2][2][4][2], const Unit& u, int wr, int wc, int fr, int fq) const {
        const int row0 = u.pm * BM + wr * 64 + fr, col0 = u.pn * HALF + wc * 32 + 8 * fq;
        float rs[2][4]; row_rstd(ss, row0, rs);
#pragma unroll
        for (int ai = 0; ai < 2; ++ai)
#pragma unroll
            for (int m = 0; m < 4; ++m) { bf16_t* rowp = O + (size_t)(row0 + ai * HALF + m * 16) * ldc + col0;
                const f32x4 g0 = acc[ai][0][m][0] * rs[ai][m], g1 = acc[ai][0][m][1] * rs[ai][m], u0 = acc[ai][1][m][0] * rs[ai][m], u1 = acc[ai][1][m][1] * rs[ai][m];
                u32x4 w;
                w.x = cvt_pk_bf16(silu_mul(g0[0], u0[0]), silu_mul(g0[1], u0[1])); w.y = cvt_pk_bf16(silu_mul(g0[2], u0[2]), silu_mul(g0[3], u0[3]));
                w.z = cvt_pk_bf16(silu_mul(g1[0], u1[0]), silu_mul(g1[1], u1[1])); w.w = cvt_pk_bf16(silu_mul(g1[2], u1[2]), silu_mul(g1[3], u1[3]));
                *(u32x4*)rowp = w; }
    }
};
struct EpiResB {
    static constexpr bool PERM = true, AFTER_DRAIN = false;
    bf16_t* XB; float* OUT; int ldc; float scale; unsigned long long* ss_out;
    __device__ __forceinline__ void operator()(const f32x4 (&acc)[2][2][4][2], const Unit& u, int wr, int wc, int fr, int fq) const {
        const int row0 = u.pm * BM + wr * 64 + fr, col0 = u.pn * BM + wc * 32 + 8 * fq;
#pragma unroll
        for (int ai = 0; ai < 2; ++ai) {
            u32x4 xo[4][2];
#pragma unroll
            for (int m = 0; m < 4; ++m)
#pragma unroll
                for (int bj = 0; bj < 2; ++bj) xo[m][bj] = *(const u32x4*)(XB + (size_t)(row0 + ai * HALF + m * 16) * ldc + col0 + bj * HALF);
#pragma unroll
            for (int m = 0; m < 4; ++m) { const size_t off = (size_t)(row0 + ai * HALF + m * 16) * ldc + col0; float sq = 0.f;
#pragma unroll
                for (int bj = 0; bj < 2; ++bj) { const u32x4 x = xo[m][bj];
                    const f32x4 v0 = (f32x4){__uint_as_float(x.x << 16), __uint_as_float(x.x & 0xffff0000u), __uint_as_float(x.y << 16), __uint_as_float(x.y & 0xffff0000u)} + acc[ai][bj][m][0] * scale;
                    const f32x4 v1 = (f32x4){__uint_as_float(x.z << 16), __uint_as_float(x.z & 0xffff0000u), __uint_as_float(x.w << 16), __uint_as_float(x.w & 0xffff0000u)} + acc[ai][bj][m][1] * scale;
                    sq += v0[0] * v0[0] + v0[1] * v0[1] + v0[2] * v0[2] + v0[3] * v0[3] + v1[0] * v1[0] + v1[1] * v1[1] + v1[2] * v1[2] + v1[3] * v1[3];
                    if (OUT) { *(f32x4*)(OUT + off + bj * HALF) = v0; *(f32x4*)(OUT + off + bj * HALF + 4) = v1; }
                    else { u32x4 w; w.x = cvt_pk_bf16(v0[0], v0[1]); w.y = cvt_pk_bf16(v0[2], v0[3]); w.z = cvt_pk_bf16(v1[0], v1[1]); w.w = cvt_pk_bf16(v1[2], v1[3]); *(u32x4*)(XB + off + bj * HALF) = w; } }
                if (ss_out) { sq += __shfl_xor(sq, 16); sq += __shfl_xor(sq, 32); if (fq == 0) atomicAdd(ss_out + row0 + ai * HALF + m * 16, (unsigned long long)(sq * 1048576.0f)); } }
        }
    }
};

template <class Epi, class Sched, bool STAMP = false>
__device__ __forceinline__ void gemm_phase(PG8_LAS unsigned char* lds, const Gemm g, const Sched& S, const Epi& E, unsigned long long* stamps) {
    const int tid = threadIdx.x, wid = __builtin_amdgcn_readfirstlane(tid >> 6), lane = tid & 63, wr = wid >> 2, wc = wid & 3, fr = lane & 15, fq = lane >> 4;
    const int K = g.K, nt = K / BK;
    int ts_lo = 0, ts_hi = 0, nts = 0; const unsigned long long rt_entry = STAMP ? (unsigned long long)wall_clock64() : 0ull;
#define PG8_STAMP() do { if (STAMP && wid == 0 && nts < 64) { const unsigned long long _c = (unsigned long long)clock64(); \
        ts_lo = (lane == nts) ? (int)(unsigned)_c : ts_lo; ts_hi = (lane == nts) ? (int)(unsigned)(_c >> 32) : ts_hi; ++nts; } } while (0)
    PG8_STAMP();
    unsigned voffA[2], voffB[2];
#pragma unroll
    for (int i = 0; i < 2; ++i) { int R, C; stage_rc(tid * 16 + i * 8192, R, C); const int Rb = Epi::PERM ? ((R & ~31) + perm32(R & 31)) : R;
        voffA[i] = (unsigned)(R * K + C) * 2u; voffB[i] = (unsigned)(Rb * K + C) * 2u; }
    const size_t kstep = (size_t)(BK * 2);
    const size_t hstep = (size_t)HALF * K * 2;
    const size_t tstep = 2 * hstep;
    const unsigned ldsw = (unsigned)wid * 1024u;
    const int aoff = lds_byte(wr * 64 + fr, fq * 8), boff = lds_byte(wc * 32 + fr, fq * 8);
#define PG8_SA(b, h) (((b) * 2 + (h)) * HTB)
#define PG8_SB(b, h) ((4 + (b) * 2 + (h)) * HTB)
#define PG8_STAGE(bufoff, gbase, voff) do { _Pragma("unroll") for (int _i = 0; _i < 2; ++_i) \
        __builtin_amdgcn_global_load_lds((const unsigned*)((const char*)(gbase) + (voff)[_i]), (PG8_LAS unsigned*)(lds + (bufoff) + ldsw + _i * 8192), 16, 0, 0); } while (0)
#define PG8_LDA(dst, b, h) do { _Pragma("unroll") for (int m = 0; m < 4; ++m) _Pragma("unroll") for (int k = 0; k < 2; ++k) dst[m][k] = *(const PG8_LAS bf16x8*)(lds + PG8_SA(b, h) + aoff + m * 2048 + k * 1024); } while (0)
#define PG8_LDB(dst, b, h) do { _Pragma("unroll") for (int n = 0; n < 2; ++n) _Pragma("unroll") for (int k = 0; k < 2; ++k) dst[n][k] = *(const PG8_LAS bf16x8*)(lds + PG8_SB(b, h) + boff + n * 2048 + k * 1024); } while (0)
#define PG8_MMA(ai, bj, At, Bt) do { __builtin_amdgcn_s_setprio(1); _Pragma("unroll") for (int m = 0; m < 4; ++m) _Pragma("unroll") for (int n = 0; n < 2; ++n) _Pragma("unroll") for (int k = 0; k < 2; ++k) \
        acc[ai][bj][m][n] = __builtin_amdgcn_mfma_f32_16x16x32_bf16(Bt[n][k], At[m][k], acc[ai][bj][m][n], 0, 0, 0); __builtin_amdgcn_s_setprio(0); } while (0)
#define PG8_WAIT_V(n) asm volatile("s_waitcnt vmcnt(" #n ")" ::: "memory")
#define PG8_WAIT_L(n) asm volatile("s_waitcnt lgkmcnt(" #n ")" ::: "memory")
#define PG8_BAR __builtin_amdgcn_s_barrier()
#define PG8_SCHED __builtin_amdgcn_sched_barrier(0)
    Unit cur, nxt; int ui = 0;
    if (!S.next(0, cur)) return;
    f32x4 acc[2][2][4][2];
#pragma unroll
    for (int a = 0; a < 2; ++a)
#pragma unroll
        for (int b = 0; b < 2; ++b)
#pragma unroll
            for (int m = 0; m < 4; ++m)
#pragma unroll
                for (int n = 0; n < 2; ++n) acc[a][b][m][n] = (f32x4){0.f, 0.f, 0.f, 0.f};
    bf16x8 At[4][2], B0[2][2], B1[2][2];
    const char* cA = (const char*)g.A + (size_t)cur.pm * tstep; const char* cB = (const char*)g.Bt + (size_t)cur.pn * tstep;
    S.a_ready(cur);
    PG8_STAGE(PG8_SB(0, 0), cB, voffB); PG8_STAGE(PG8_SA(0, 0), cA, voffA); PG8_STAGE(PG8_SB(0, 1), cB + hstep, voffB); PG8_STAGE(PG8_SA(0, 1), cA + hstep, voffA);
    if (wr == 1) PG8_BAR;
    PG8_WAIT_V(4); PG8_BAR;
    PG8_STAGE(PG8_SB(1, 0), cB + kstep, voffB); PG8_STAGE(PG8_SA(1, 0), cA + kstep, voffA); PG8_STAGE(PG8_SB(1, 1), cB + hstep + kstep, voffB);
    PG8_WAIT_V(6); PG8_BAR;
    PG8_STAMP();
    for (;;) {
        const bool has_next = S.next(ui + 1, nxt);
        const char* nA = has_next ? (const char*)g.A + (size_t)nxt.pm * tstep : cA; const char* nB = has_next ? (const char*)g.Bt + (size_t)nxt.pn * tstep : cB;
        for (int t = 0; t < nt; t += 2) {
            const bool last = (t == nt - 2);
            const char* a1 = cA + (size_t)(t + 1) * kstep;
            const char* a2 = last ? nA : cA + (size_t)(t + 2) * kstep; const char* b2 = last ? nB : cB + (size_t)(t + 2) * kstep;
            const char* a3 = a2 + kstep; const char* b3 = b2 + kstep;
            if (last && has_next) S.a_ready(nxt);
            PG8_LDB(B0, 0, 0); PG8_SCHED; PG8_LDA(At, 0, 0); PG8_STAGE(PG8_SA(1, 1), a1 + hstep, voffA);
            PG8_WAIT_L(8); PG8_BAR; PG8_WAIT_L(0); PG8_MMA(0, 0, At, B0); PG8_BAR; PG8_SCHED;
            PG8_LDB(B1, 0, 1); PG8_STAGE(PG8_SB(0, 0), b2, voffB);
            PG8_BAR; PG8_WAIT_L(0); PG8_MMA(0, 1, At, B1); PG8_BAR;
            PG8_LDA(At, 0, 1); PG8_STAGE(PG8_SA(0, 0), a2, voffA);
            PG8_BAR; PG8_WAIT_L(0); PG8_MMA(1, 0, At, B0); PG8_BAR; PG8_SCHED;
            PG8_STAGE(PG8_SB(0, 1), b2 + hstep, voffB);
            PG8_WAIT_V(6); PG8_BAR; PG8_MMA(1, 1, At, B1); PG8_BAR;
            PG8_LDB(B0, 1, 0); PG8_SCHED; PG8_LDA(At, 1, 0); PG8_STAGE(PG8_SA(0, 1), a2 + hstep, voffA);
            PG8_WAIT_L(8); PG8_BAR; PG8_WAIT_L(0); PG8_MMA(0, 0, At, B0); PG8_BAR; PG8_SCHED;
            PG8_LDB(B1, 1, 1); PG8_STAGE(PG8_SB(1, 0), b3, voffB);
            PG8_BAR; PG8_WAIT_L(0); PG8_MMA(0, 1, At, B1); PG8_BAR;
            PG8_LDA(At, 1, 1); PG8_STAGE(PG8_SA(1, 0), a3, voffA);
            PG8_BAR; PG8_WAIT_L(0); PG8_MMA(1, 0, At, B0); PG8_BAR; PG8_SCHED;
            PG8_STAGE(PG8_SB(1, 1), b3 + hstep, voffB);
            PG8_WAIT_V(6); PG8_BAR; PG8_MMA(1, 1, At, B1); PG8_BAR;
        }
        PG8_STAMP();
        if constexpr (!Epi::AFTER_DRAIN) { E(acc, cur, wr, wc, fr, fq); S.done(cur); }
        PG8_STAMP();
        if (!has_next) break;
#pragma unroll
        for (int a = 0; a < 2; ++a)
#pragma unroll
            for (int b = 0; b < 2; ++b)
#pragma unroll
                for (int m = 0; m < 4; ++m)
#pragma unroll
                    for (int n = 0; n < 2; ++n) acc[a][b][m][n] = (f32x4){0.f, 0.f, 0.f, 0.f};
        cur = nxt; cA = nA; cB = nB; ++ui;
    }
    PG8_WAIT_V(0);
    if (wr == 0) PG8_BAR;
    PG8_BAR;
    if constexpr (Epi::AFTER_DRAIN) { E.fused(acc, cur, wr, wc, fr, fq, lds, wid, lane); S.done(cur); }
    PG8_STAMP();
    if (STAMP && wid == 0) { stamps[lane] = lane < nts ? (((unsigned long long)(unsigned)ts_hi << 32) | (unsigned)ts_lo) : 0ull;
        if (lane == 62) stamps[62] = rt_entry; if (lane == 63) stamps[63] = (unsigned long long)wall_clock64(); }
#undef PG8_STAMP
#undef PG8_SA
#undef PG8_SB
#undef PG8_STAGE
#undef PG8_LDA
#undef PG8_LDB
#undef PG8_MMA
#undef PG8_WAIT_V
#undef PG8_WAIT_L
#undef PG8_BAR
#undef PG8_SCHED
}
}

#define LAS __attribute__((address_space(3)))
typedef unsigned short bf16_t;
typedef short bf16x8 __attribute__((ext_vector_type(8)));
typedef float f32x4 __attribute__((ext_vector_type(4)));
typedef unsigned u32x4 __attribute__((ext_vector_type(4)));
typedef unsigned u32x2 __attribute__((ext_vector_type(2)));

constexpr int MTOK = 16384, DM = 2048, DFF = 5632, NPROJ = 4608, SEQ = 4096, NB = 4;
constexpr int NTHREADS = 512;
constexpr int BAR_LDS_OFF = 131072;
constexpr int LDS_BYTES = 131072 + 256;
constexpr float EPS = 1e-6f;

constexpr size_t SZ_WGU = (size_t)2 * DFF * DM * 2, SZ_WDN = (size_t)DM * DFF * 2, SZ_WIN = (size_t)NPROJ * DM * 2, SZ_WOUT = (size_t)DM * DM * 2;
constexpr size_t WS_WGU = 0;
constexpr size_t WS_WDN = WS_WGU + 4 * SZ_WGU;
constexpr size_t WS_WIN = WS_WDN + 4 * SZ_WDN;
constexpr size_t WS_WOUT = WS_WIN + 2 * SZ_WIN;
constexpr size_t WS_KF = WS_WOUT + 2 * SZ_WOUT;
constexpr size_t WS_HB = WS_KF + (size_t)2 * 512 * 8192 * 2;
constexpr size_t WS_UN = WS_HB + (size_t)MTOK * DM * 2;
constexpr size_t WS_ACT = WS_UN;
constexpr size_t WS_PB = WS_UN;
constexpr size_t WS_ZVT = WS_PB + (size_t)MTOK * NPROJ * 2;
constexpr size_t WS_CONVT = WS_ZVT + (size_t)512 * 4 * 4096 * 2;
constexpr size_t WS_YAT = WS_CONVT + (size_t)512 * 4 * 4096 * 4;
constexpr size_t WS_YB = WS_YAT + (size_t)MTOK * 1024 * 2;
constexpr size_t WS_SS = WS_YB + (size_t)MTOK * DM * 2;
constexpr size_t WS_BAR = WS_SS + (size_t)6 * MTOK * 8;
constexpr size_t WS_END = WS_BAR + 16384;
static_assert(WS_END - WS_UN >= (size_t)MTOK * DFF * 2, "union region must hold ACT");

struct Params { const float* in[28]; float* out; unsigned char* ws; int ph_lo, ph_hi; };

__device__ __forceinline__ float bf2f(unsigned short b) { return __uint_as_float(((unsigned)b) << 16); }
__device__ __forceinline__ float bflo(unsigned w) { return __uint_as_float(w << 16); }
__device__ __forceinline__ float bfhi(unsigned w) { return __uint_as_float(w & 0xffff0000u); }
__device__ __forceinline__ unsigned pk2(float lo, float hi) { return pg8::cvt_pk_bf16(lo, hi); }
__device__ __forceinline__ float wave_sum(float v) {
#pragma unroll
    for (int o = 32; o >= 1; o >>= 1) v += __shfl_xor(v, o);
    return v;
}

constexpr int CV_TK = 64, CV_TN = 256, CV_LD = 260;
struct CvJob { const float* src; const float* gain; bf16_t* dst; int K, N, mode; };
constexpr int CV_T_GU = (DM / CV_TK) * (DFF / CV_TN), CV_T_DN = (DFF / CV_TK) * (DM / CV_TN), CV_T_IN = (DM / CV_TK) * (NPROJ / CV_TN), CV_T_OUT = (DM / CV_TK) * (DM / CV_TN);
constexpr int CV_PER_LAYER = 4 * CV_T_GU + 2 * CV_T_DN + CV_T_IN + CV_T_OUT;
__device__ __forceinline__ void cv_decode(const Params& p, int gt, CvJob& j, int& tk, int& tn) {
    const int l = gt / CV_PER_LAYER; int r = gt - l * CV_PER_LAYER;
    unsigned char* ws = p.ws;
    int tiles_n;
    if (r < 4 * CV_T_GU) { const int w = r / CV_T_GU; r -= w * CV_T_GU; const int f = w >> 1, up = w & 1;
        j.src = p.in[(f ? 25 : 2) + up] + (size_t)l * DM * DFF; j.gain = p.in[f ? 24 : 1] + l * DM; j.dst = (bf16_t*)(ws + WS_WGU + (size_t)(l * 2 + f) * SZ_WGU); j.K = DM; j.N = DFF; j.mode = 1 + up; tiles_n = DFF / CV_TN; }
    else if ((r -= 4 * CV_T_GU) < 2 * CV_T_DN) { const int f = r / CV_T_DN; r -= f * CV_T_DN;
        j.src = p.in[f ? 27 : 4] + (size_t)l * DFF * DM; j.gain = nullptr; j.dst = (bf16_t*)(ws + WS_WDN + (size_t)(l * 2 + f) * SZ_WDN); j.K = DFF; j.N = DM; j.mode = 0; tiles_n = DM / CV_TN; }
    else if ((r -= 2 * CV_T_DN) < CV_T_IN) {
        j.src = p.in[6] + (size_t)l * DM * NPROJ; j.gain = p.in[5] + l * DM; j.dst = (bf16_t*)(ws + WS_WIN + (size_t)l * SZ_WIN); j.K = DM; j.N = NPROJ; j.mode = 0; tiles_n = NPROJ / CV_TN; }
    else { r -= CV_T_IN;
        j.src = p.in[23] + (size_t)l * DM * DM; j.gain = p.in[22] + l * DM; j.dst = (bf16_t*)(ws + WS_WOUT + (size_t)l * SZ_WOUT); j.K = DM; j.N = DM; j.mode = 0; tiles_n = DM / CV_TN; }
    tk = r / tiles_n; tn = r - tk * tiles_n;
}
__device__ __forceinline__ void cv_load(const Params& p, int gt, f32x4 (&v)[8]) {
    CvJob j; int tk, tn; cv_decode(p, gt, j, tk, tn);
    const int tid = threadIdx.x;
#pragma unroll
    for (int it = 0; it < 8; ++it) { const int idx = tid + it * NTHREADS, k = idx >> 6, n4 = idx & 63;
        f32x4 x = __builtin_nontemporal_load((const f32x4*)(j.src + (size_t)(tk * CV_TK + k) * j.N + tn * CV_TN + n4 * 4));
        if (j.gain) x = x * j.gain[tk * CV_TK + k];
        v[it] = x; }
}
__device__ __forceinline__ void phase_convert(const Params& p, LAS unsigned char* lds) {
    LAS float* T = (LAS float*)lds;
    const int tid = threadIdx.x, G = gridDim.x;
    const int total = 2 * CV_PER_LAYER;
    int gt = blockIdx.x;
    f32x4 v[8];
    if (gt < total) cv_load(p, gt, v);
    for (; gt < total; gt += G) {
        __syncthreads();
#pragma unroll
        for (int it = 0; it < 8; ++it) { const int idx = tid + it * NTHREADS, k = idx >> 6, n4 = idx & 63; *(LAS f32x4*)(T + k * CV_LD + n4 * 4) = v[it]; }
        CvJob j; int tk, tn; cv_decode(p, gt, j, tk, tn);
        if (gt + G < total) cv_load(p, gt + G, v);
        __syncthreads();
        const int n = tid >> 1, kc = tid & 1;
        unsigned w[16];
#pragma unroll
        for (int i = 0; i < 16; ++i) w[i] = pk2(T[(kc * 32 + 2 * i) * CV_LD + n], T[(kc * 32 + 2 * i + 1) * CV_LD + n]);
        const int ng = tn * CV_TN + n;
        const int row = j.mode == 0 ? ng : ((ng >> 7) * 256 + (j.mode == 2 ? 128 : 0) + (ng & 127));
        bf16_t* d = j.dst + (size_t)row * j.K + tk * CV_TK + kc * 32;
#pragma unroll
        for (int i = 0; i < 4; ++i) *(u32x4*)(d + 8 * i) = (u32x4){w[4 * i], w[4 * i + 1], w[4 * i + 2], w[4 * i + 3]};
    }
    __syncthreads();
}

template <int KIN, int LDI> __device__ __forceinline__ void filt_layer(const float* __restrict__ w, const float* __restrict__ bias, const float* __restrict__ fr, const LAS float* hin, LAS float* hout) {
    const int tid = threadIdx.x, j = tid & 63, pg = tid >> 6;
    float a[4]; const float bj = bias[j];
#pragma unroll
    for (int i = 0; i < 4; ++i) a[i] = bj;
#pragma unroll 8
    for (int e = 0; e < KIN; ++e) { const float wv = w[e * 64 + j];
#pragma unroll
        for (int i = 0; i < 4; ++i) a[i] += hin[(pg * 4 + i) * LDI + e] * wv; }
    const float f = fr[j];
#pragma unroll
    for (int i = 0; i < 4; ++i) hout[(pg * 4 + i) * 64 + j] = sinf(f * a[i]);
}
__device__ __forceinline__ void phase_filter(const Params& p, LAS unsigned char* lds) {
    LAS float* zs = (LAS float*)lds;
    LAS float* h1 = zs + 32 * 36;
    LAS float* h2 = h1 + 32 * 64;
    LAS float* h3 = h2 + 32 * 64;
    const int tid = threadIdx.x, G = gridDim.x;
    bf16_t* KF = (bf16_t*)(p.ws + WS_KF);
    for (int u = blockIdx.x; u < 256; u += G) {
        const int l = u >> 7, n0 = (u & 127) * 32;
        const float* fr = p.in[15] + l * 64; const float* __restrict__ wo = p.in[16] + (size_t)l * 64 * 1024;
        __syncthreads();
        for (int idx = tid; idx < 32 * 33; idx += NTHREADS) { const int pp = idx / 33, e = idx - pp * 33; const float n = (float)(n0 + pp);
            float val;
            if (e == 0) val = n / 4095.0f;
            else { const int k = (e - 1) & 15; const float band = 1e-4f + (float)k * ((15.0f - 1e-4f) / 15.0f); const float ang = (6.283185307179586f / 4096.0f) * n * band;
                val = (e <= 16) ? cosf(ang) : sinf(ang); }
            zs[pp * 36 + e] = val; }
        __syncthreads();
        filt_layer<33, 36>(p.in[9] + l * 33 * 64, p.in[10] + l * 64, fr, zs, h1);
        __syncthreads();
        filt_layer<64, 64>(p.in[11] + l * 64 * 64, p.in[12] + l * 64, fr, h1, h2);
        __syncthreads();
        filt_layer<64, 64>(p.in[13] + l * 64 * 64, p.in[14] + l * 64, fr, h2, h3);
        __syncthreads();
        float af[32], ab[32];
#pragma unroll
        for (int pp = 0; pp < 32; ++pp) { af[pp] = 0.f; ab[pp] = 0.f; }
        for (int k4 = 0; k4 < 16; ++k4) {
            float wa[4], wb[4];
#pragma unroll
            for (int i = 0; i < 4; ++i) { wa[i] = wo[(k4 * 4 + i) * 1024 + tid]; wb[i] = wo[(k4 * 4 + i) * 1024 + 512 + tid]; }
#pragma unroll
            for (int pp = 0; pp < 32; ++pp) { const f32x4 hv = *(const LAS f32x4*)(h3 + pp * 64 + k4 * 4);
                af[pp] += hv[0] * wa[0] + hv[1] * wa[1] + hv[2] * wa[2] + hv[3] * wa[3];
                ab[pp] += hv[0] * wb[0] + hv[1] * wb[1] + hv[2] * wb[2] + hv[3] * wb[3]; }
        }
        const int c = tid;
        const float dlo = -3.0701134573253945f, dhi = -15.350567286626973f;
        const float delta = fabsf(dlo + (float)c * ((dhi - dlo) / 511.0f));
#pragma unroll
        for (int pp = 0; pp < 32; ++pp) { const float t = (float)(n0 + pp) / 4095.0f; const float win = expf(-t * delta) + 0.05f; af[pp] *= win; ab[pp] *= win; }
        bf16_t* kc = KF + ((size_t)l * 512 + c) * 8192;
#pragma unroll
        for (int i = 0; i < 4; ++i) *(u32x4*)(kc + 4096 + n0 + 8 * i) = (u32x4){pk2(af[8 * i], af[8 * i + 1]), pk2(af[8 * i + 2], af[8 * i + 3]), pk2(af[8 * i + 4], af[8 * i + 5]), pk2(af[8 * i + 6], af[8 * i + 7])};
        if (n0 == 0) kc[0] = 0;
        bf16_t* kb = kc + 4065 - n0;
#define BW(jx) ab[31 - (jx)]
        kb[0] = (bf16_t)(pk2(BW(0), 0.f) & 0xffffu);
        *(unsigned*)(kb + 1) = pk2(BW(1), BW(2));
        *(u32x2*)(kb + 3) = (u32x2){pk2(BW(3), BW(4)), pk2(BW(5), BW(6))};
#pragma unroll
        for (int i = 0; i < 3; ++i) *(u32x4*)(kb + 7 + 8 * i) = (u32x4){pk2(BW(7 + 8 * i), BW(8 + 8 * i)), pk2(BW(9 + 8 * i), BW(10 + 8 * i)), pk2(BW(11 + 8 * i), BW(12 + 8 * i)), pk2(BW(13 + 8 * i), BW(14 + 8 * i))};
        if (n0 != 0) kb[31] = (bf16_t)(pk2(BW(31), 0.f) & 0xffffu);
#undef BW
    }
    __syncthreads();
}

__device__ __forceinline__ void phase_x0(const float* x, bf16_t* xb, unsigned long long* ss) {
    const int lane = threadIdx.x & 63, wave = threadIdx.x >> 6;
    const int gw = blockIdx.x * 8 + wave, nw = gridDim.x * 8;
    for (int i = blockIdx.x * NTHREADS + threadIdx.x; i < 5 * MTOK; i += gridDim.x * NTHREADS) ss[MTOK + i] = 0ull;
    for (int row = gw; row < MTOK; row += nw) {
        const float* xr = x + (size_t)row * DM;
        f32x4 v[8]; float sq = 0.f;
#pragma unroll
        for (int i = 0; i < 8; ++i) v[i] = __builtin_nontemporal_load((const f32x4*)(xr + i * 256 + lane * 4));
#pragma unroll
        for (int i = 0; i < 8; ++i) sq += v[i][0] * v[i][0] + v[i][1] * v[i][1] + v[i][2] * v[i][2] + v[i][3] * v[i][3];
        sq = wave_sum(sq);
        if (lane == 0) ss[row] = (unsigned long long)(sq * 1048576.0f);
        bf16_t* hr = xb + (size_t)row * DM;
#pragma unroll
        for (int i = 0; i < 8; ++i) *(u32x2*)(hr + i * 256 + lane * 4) = (u32x2){pk2(v[i][0], v[i][1]), pk2(v[i][2], v[i][3])};
    }
}

__device__ __forceinline__ void phase_hyprep(const Params& p, int l) {
    const bf16_t* PB = (const bf16_t*)(p.ws + WS_PB); bf16_t* ZVT = (bf16_t*)(p.ws + WS_ZVT);
    const float* sw = p.in[7] + l * 3 * 1536; const float* sb = p.in[8] + l * 1536;
    const int lane = threadIdx.x & 63, wave = threadIdx.x >> 6;
    const int gw = blockIdx.x * 8 + wave, nw = gridDim.x * 8;
    for (int task = gw; task < 4096; task += nw) {
        const int tg = task >> 1, ch = task & 1; const int c = ch * 256 + lane * 4;
        const int tglob = tg * 8, b = tglob >> 12, t0 = tglob & 4095;
        f32x4 w1[3], wv[3];
#pragma unroll
        for (int j = 0; j < 3; ++j) { w1[j] = *(const f32x4*)(sw + j * 1536 + 512 + c); wv[j] = *(const f32x4*)(sw + j * 1536 + 1024 + c); }
        const f32x4 bb1 = *(const f32x4*)(sb + 512 + c), bbv = *(const f32x4*)(sb + 1024 + c);
        f32x4 r1[10], rv[10];
#pragma unroll
        for (int i = 0; i < 10; ++i) { const int t = t0 - 1 + i;
            if (t >= 0 && t < SEQ) { const bf16_t* row = PB + (size_t)(b * SEQ + t) * NPROJ;
                const u32x2 a = *(const u32x2*)(row + 512 + c), d = *(const u32x2*)(row + 1024 + c);
                r1[i] = (f32x4){bflo(a.x), bfhi(a.x), bflo(a.y), bfhi(a.y)}; rv[i] = (f32x4){bflo(d.x), bfhi(d.x), bflo(d.y), bfhi(d.y)}; }
            else { r1[i] = (f32x4){0.f, 0.f, 0.f, 0.f}; rv[i] = r1[i]; } }
        f32x4 zv[8];
#pragma unroll
        for (int i = 0; i < 8; ++i) { const f32x4 x1 = w1[0] * r1[i] + w1[1] * r1[i + 1] + w1[2] * r1[i + 2] + bb1; const f32x4 vv = wv[0] * rv[i] + wv[1] * rv[i + 1] + wv[2] * rv[i + 2] + bbv; zv[i] = x1 * vv; }
#pragma unroll
        for (int e = 0; e < 4; ++e) { const u32x4 w = (u32x4){pk2(zv[0][e], zv[1][e]), pk2(zv[2][e], zv[3][e]), pk2(zv[4][e], zv[5][e]), pk2(zv[6][e], zv[7][e])};
            *(u32x4*)(ZVT + ((size_t)(c + e) * 4 + b) * SEQ + t0) = w; }
    }
}

constexpr int HY_VS = 0, HY_ZS = 66560, HY_TMP = HY_ZS + 4 * 64 * 144;
__device__ __forceinline__ void hyena_conv_unit(LAS unsigned char* lds, const bf16_t* KFc, const bf16_t* ZVc, float* CONVc) {
    const int tid = threadIdx.x, lane = tid & 63, wid = tid >> 6, r = lane & 15, q = lane >> 4;
    const int b = wid >> 1, ib = (wid & 1) * 32;
    __syncthreads();
#pragma unroll
    for (int k = 0; k < 4; ++k) { const int idx = tid + k * NTHREADS; const int bb = idx >> 9, ch = idx & 511;
        const u32x4 v = *(const u32x4*)(ZVc + bb * SEQ + ch * 8);
        *(LAS u32x4*)(lds + HY_ZS + bb * 9216 + (ch >> 3) * 144 + (ch & 7) * 16) = v; }
    f32x4 acc[4][2];
#pragma unroll
    for (int m = 0; m < 4; ++m) { acc[m][0] = (f32x4){0.f, 0.f, 0.f, 0.f}; acc[m][1] = acc[m][0]; }
    LAS unsigned short* TMP = (LAS unsigned short*)(lds + HY_TMP);
    for (int hf = 0; hf < 2; ++hf) {
        const int xlo = hf ? -56 : -4088, cnt = hf ? 4152 : 4088;
        __syncthreads();
        for (int e = tid; e < cnt + 7; e += NTHREADS) TMP[e] = KFc[4096 + xlo - 7 + e];
        __syncthreads();
        for (int e = tid; e < cnt; e += NTHREADS) {
            unsigned w[4];
#pragma unroll
            for (int i = 0; i < 4; ++i) w[i] = (unsigned)TMP[e + 7 - 2 * i] | ((unsigned)TMP[e + 6 - 2 * i] << 16);
            *(LAS u32x4*)(lds + HY_VS + e * 16) = (u32x4){w[0], w[1], w[2], w[3]}; }
        __syncthreads();
        const int dlo = hf ? 0 : -63, dhi = hf ? 63 : -1;
        for (int d = dlo; d <= dhi; ++d) {
            if (ib + 31 - d < 0 || ib - d > 63) continue;
            const int base = 64 * d + r - 8 * q - xlo;
            bf16x8 Af[6];
#pragma unroll
            for (int bi = 0; bi < 6; ++bi) Af[bi] = *(const LAS bf16x8*)(lds + HY_VS + (base - 32 + 16 * bi) * 16);
#pragma unroll
            for (int nt = 0; nt < 2; ++nt) {
                const int i0 = ib + 16 * nt;
                if (i0 + 15 - d < 0 || i0 - d > 63) continue;
                const int j = i0 + r - d; const bool valid = (unsigned)j < 64u; const int jc = valid ? j : 0;
                bf16x8 Bf[2];
#pragma unroll
                for (int kk = 0; kk < 2; ++kk) { bf16x8 t = *(const LAS bf16x8*)(lds + HY_ZS + b * 9216 + jc * 144 + kk * 64 + q * 16);
                    if (!valid) t = (bf16x8){0, 0, 0, 0, 0, 0, 0, 0};
                    Bf[kk] = t; }
#pragma unroll
                for (int kk = 0; kk < 2; ++kk)
#pragma unroll
                    for (int m = 0; m < 4; ++m) acc[m][nt] = __builtin_amdgcn_mfma_f32_16x16x32_bf16(Af[m - 2 * kk + 2], Bf[kk], acc[m][nt], 0, 0, 0);
            }
        }
    }
#pragma unroll
    for (int nt = 0; nt < 2; ++nt)
#pragma unroll
        for (int m = 0; m < 4; ++m) *(f32x4*)(CONVc + b * SEQ + 64 * (ib + 16 * nt + r) + 16 * m + 4 * q) = acc[m][nt];
}

constexpr int AT_KS = 0, AT_KS_LD = 144, AT_VT = 384 * 144, AT_VT_LD = 784;
__device__ __forceinline__ void attn_unit(LAS unsigned char* lds, const bf16_t* PB, bf16_t* YAT, int u, const float* qg, const float* kg, const float* sink) {
    const int tid = threadIdx.x, lane = tid & 63, wid = tid >> 6, r = lane & 15, q = lane >> 4;
    const int b = u >> 7, nb = (u & 127) >> 2, kvh = u & 3;
    __syncthreads();
    u32x4 kraw[6], vraw[6];
#pragma unroll
    for (int k = 0; k < 6; ++k) { const int idx = tid + k * NTHREADS; const int key = idx >> 3, ch = idx & 7; const int kpos = 128 * (nb - 1) + key;
        const bool inr = kpos >= 0 && kpos < SEQ;
        const bf16_t* src = PB + (size_t)(b * SEQ + (inr ? kpos : 0)) * NPROJ + kvh * 64 + ch * 8;
        kraw[k] = *(const u32x4*)(src + 4096); vraw[k] = *(const u32x4*)(src + 4352); }
    const int g = wid >> 1, h = kvh * 4 + g;
    const bf16_t* qsrc = PB + (size_t)(b * SEQ + 128 * nb + (wid & 1) * 64 + r) * NPROJ + 3072 + h * 64 + q * 8;
    u32x4 qn0 = *(const u32x4*)(qsrc), qn1 = *(const u32x4*)(qsrc + 32);
#pragma unroll
    for (int k = 0; k < 6; ++k) { const int idx = tid + k * NTHREADS; const int key = idx >> 3, ch = idx & 7; const int kpos = 128 * (nb - 1) + key;
        const bool inr = kpos >= 0 && kpos < SEQ;
        u32x4 kv = kraw[k], vv = vraw[k];
        if (!inr) { kv = (u32x4){0u, 0u, 0u, 0u}; vv = kv; }
        float kf[8] = {bflo(kv.x), bfhi(kv.x), bflo(kv.y), bfhi(kv.y), bflo(kv.z), bfhi(kv.z), bflo(kv.w), bfhi(kv.w)};
        float ss = 0.f;
#pragma unroll
        for (int i = 0; i < 8; ++i) ss += kf[i] * kf[i];
        ss += __shfl_xor(ss, 1); ss += __shfl_xor(ss, 2); ss += __shfl_xor(ss, 4);
        const float rs = rsqrtf(ss * (1.0f / 64.0f) + EPS);
        const f32x4 g0 = *(const f32x4*)(kg + ch * 8), g1 = *(const f32x4*)(kg + ch * 8 + 4);
        const u32x4 ko = (u32x4){pk2(kf[0] * rs * g0[0], kf[1] * rs * g0[1]), pk2(kf[2] * rs * g0[2], kf[3] * rs * g0[3]), pk2(kf[4] * rs * g1[0], kf[5] * rs * g1[1]), pk2(kf[6] * rs * g1[2], kf[7] * rs * g1[3])};
        *(LAS u32x4*)(lds + AT_KS + key * AT_KS_LD + ch * 16) = ko;
        const unsigned vw[4] = {vv.x, vv.y, vv.z, vv.w};
#pragma unroll
        for (int i = 0; i < 8; ++i) *(LAS unsigned short*)(lds + AT_VT + (ch * 8 + i) * AT_VT_LD + key * 2) = (unsigned short)((i & 1) ? (vw[i >> 1] >> 16) : (vw[i >> 1] & 0xffffu));
    }
    __syncthreads();
    const float slope = exp2f(-0.5f * (float)(h + 1)), snk = sink[h];
    for (int si = 0; si < 4; ++si) {
        const int q0 = ((wid & 1) * 4 + si) * 16; const int qpos = 128 * nb + q0 + r;
        const u32x4 qc0 = qn0, qc1 = qn1;
        if (si < 3) { qn0 = *(const u32x4*)(qsrc + (size_t)(si + 1) * 16 * NPROJ); qn1 = *(const u32x4*)(qsrc + (size_t)(si + 1) * 16 * NPROJ + 32); }
        bf16x8 Qf[2];
        {
            const u32x4 a0 = qc0, a1 = qc1;
            float f0[8] = {bflo(a0.x), bfhi(a0.x), bflo(a0.y), bfhi(a0.y), bflo(a0.z), bfhi(a0.z), bflo(a0.w), bfhi(a0.w)};
            float f1[8] = {bflo(a1.x), bfhi(a1.x), bflo(a1.y), bfhi(a1.y), bflo(a1.z), bfhi(a1.z), bflo(a1.w), bfhi(a1.w)};
            float ss = 0.f;
#pragma unroll
            for (int i = 0; i < 8; ++i) ss += f0[i] * f0[i] + f1[i] * f1[i];
            ss += __shfl_xor(ss, 16); ss += __shfl_xor(ss, 32);
            const float rs = rsqrtf(ss * (1.0f / 64.0f) + EPS) * 0.125f;
            const f32x4 ga = *(const f32x4*)(qg + q * 8), gb = *(const f32x4*)(qg + q * 8 + 4), gc = *(const f32x4*)(qg + 32 + q * 8), gd = *(const f32x4*)(qg + 32 + q * 8 + 4);
            const u32x4 w0 = (u32x4){pk2(f0[0] * rs * ga[0], f0[1] * rs * ga[1]), pk2(f0[2] * rs * ga[2], f0[3] * rs * ga[3]), pk2(f0[4] * rs * gb[0], f0[5] * rs * gb[1]), pk2(f0[6] * rs * gb[2], f0[7] * rs * gb[3])};
            const u32x4 w1 = (u32x4){pk2(f1[0] * rs * gc[0], f1[1] * rs * gc[1]), pk2(f1[2] * rs * gc[2], f1[3] * rs * gc[3]), pk2(f1[4] * rs * gd[0], f1[5] * rs * gd[1]), pk2(f1[6] * rs * gd[2], f1[7] * rs * gd[3])};
            Qf[0] = __builtin_bit_cast(bf16x8, w0); Qf[1] = __builtin_bit_cast(bf16x8, w1);
        }
        const int kt0 = q0 >> 4;
        f32x4 S[17];
#pragma unroll
        for (int tt = 0; tt < 17; ++tt) {
            const LAS unsigned char* kp = lds + AT_KS + (16 * (kt0 + tt) + r) * AT_KS_LD + q * 16;
            const bf16x8 k0 = *(const LAS bf16x8*)kp, k1 = *(const LAS bf16x8*)(kp + 64);
            f32x4 s = __builtin_amdgcn_mfma_f32_16x16x32_bf16(k0, Qf[0], (f32x4){0.f, 0.f, 0.f, 0.f}, 0, 0, 0);
            S[tt] = __builtin_amdgcn_mfma_f32_16x16x32_bf16(k1, Qf[1], s, 0, 0, 0);
        }
        float mx = snk;
#pragma unroll
        for (int tt = 0; tt < 17; ++tt)
#pragma unroll
            for (int jj = 0; jj < 4; ++jj) { const int kl = 16 * (kt0 + tt) + 4 * q + jj; const int kpos = 128 * (nb - 1) + kl;
                int dist = 128 + q0 + r - kl; dist = dist < 0 ? -dist : dist;
                const bool valid = dist <= 128 && kpos >= 0 && kpos < SEQ;
                const float lg = valid ? S[tt][jj] - slope * (float)dist : -1e30f;
                S[tt][jj] = lg; mx = fmaxf(mx, lg); }
        mx = fmaxf(mx, __shfl_xor(mx, 16)); mx = fmaxf(mx, __shfl_xor(mx, 32));
        float sum = 0.f;
#pragma unroll
        for (int tt = 0; tt < 17; ++tt)
#pragma unroll
            for (int jj = 0; jj < 4; ++jj) { const float pe = __expf(S[tt][jj] - mx); S[tt][jj] = pe; sum += pe; }
        sum += __shfl_xor(sum, 16); sum += __shfl_xor(sum, 32);
        const float inv = 1.0f / (sum + __expf(snk - mx));
        f32x4 O[4];
#pragma unroll
        for (int dt = 0; dt < 4; ++dt) O[dt] = (f32x4){0.f, 0.f, 0.f, 0.f};
#pragma unroll
        for (int pr = 0; pr < 9; ++pr) {
            const int t0 = 2 * pr, t1 = 2 * pr + 1;
            u32x4 pw; pw.x = pk2(S[t0][0], S[t0][1]); pw.y = pk2(S[t0][2], S[t0][3]);
            if (t1 < 17) { pw.z = pk2(S[t1 < 17 ? t1 : 16][0], S[t1 < 17 ? t1 : 16][1]); pw.w = pk2(S[t1 < 17 ? t1 : 16][2], S[t1 < 17 ? t1 : 16][3]); } else { pw.z = 0u; pw.w = 0u; }
            const bf16x8 Pf = __builtin_bit_cast(bf16x8, pw);
#pragma unroll
            for (int dt = 0; dt < 4; ++dt) {
                const LAS unsigned char* vp = lds + AT_VT + (16 * dt + r) * AT_VT_LD + (16 * (kt0 + t0) + 4 * q) * 2;
                const u32x2 lo = *(const LAS u32x2*)vp; u32x2 hi = (u32x2){0u, 0u};
                if (t1 < 17) hi = *(const LAS u32x2*)(vp + 32);
                const bf16x8 Vf = __builtin_bit_cast(bf16x8, (u32x4){lo.x, lo.y, hi.x, hi.y});
                O[dt] = __builtin_amdgcn_mfma_f32_16x16x32_bf16(Vf, Pf, O[dt], 0, 0, 0);
            }
        }
        bf16_t* dst = YAT + (size_t)(b * SEQ + qpos) * 1024 + h * 64 + 4 * q;
#pragma unroll
        for (int dt = 0; dt < 4; ++dt) *(u32x2*)(dst + 16 * dt) = (u32x2){pk2(O[dt][0] * inv, O[dt][1] * inv), pk2(O[dt][2] * inv, O[dt][3] * inv)};
    }
}

__device__ __forceinline__ void phase_mix(const Params& p, int l, LAS unsigned char* lds) {
    const int G = gridDim.x;
    const bf16_t* PB = (const bf16_t*)(p.ws + WS_PB);
    for (int c = blockIdx.x; c < 512; c += G)
        hyena_conv_unit(lds, (const bf16_t*)(p.ws + WS_KF) + ((size_t)l * 512 + c) * 8192, (const bf16_t*)(p.ws + WS_ZVT) + (size_t)c * 4 * SEQ, (float*)(p.ws + WS_CONVT) + (size_t)c * 4 * SEQ);
    for (int u = blockIdx.x; u < 512; u += G)
        attn_unit(lds, PB, (bf16_t*)(p.ws + WS_YAT), u, p.in[19] + l * 64, p.in[20] + l * 64, p.in[21] + l * 16);
    __syncthreads();
}

constexpr int PO_LD = 516;
__device__ __forceinline__ void ld8(const bf16_t* p, bool ok, float (&f)[8]) {
    u32x4 a = (u32x4){0u, 0u, 0u, 0u}; if (ok) a = *(const u32x4*)p;
    f[0] = bflo(a.x); f[1] = bfhi(a.x); f[2] = bflo(a.y); f[3] = bfhi(a.y); f[4] = bflo(a.z); f[5] = bfhi(a.z); f[6] = bflo(a.w); f[7] = bfhi(a.w);
}
__device__ __forceinline__ void phase_post(const Params& p, int l, LAS unsigned char* lds) {
    LAS float* Cs = (LAS float*)lds;
    const int tid = threadIdx.x, lane = tid & 63, wid = tid >> 6, G = gridDim.x;
    const bf16_t* PB = (const bf16_t*)(p.ws + WS_PB); const float* CONVT = (const float*)(p.ws + WS_CONVT); const bf16_t* YAT = (const bf16_t*)(p.ws + WS_YAT);
    bf16_t* YB = (bf16_t*)(p.ws + WS_YB);
    const float* sw = p.in[7] + l * 3 * 1536; const float* sb = p.in[8] + l * 1536; const float* bd = p.in[17] + l * 512; const float* cw = p.in[18] + l * 3 * 512;
    const int c = lane * 8;
    for (int u = blockIdx.x; u < MTOK / 32; u += G) {
        const int tg0 = u * 32, b = tg0 >> 12, tt = tg0 & 4095;
        __syncthreads();
#pragma unroll
        for (int k = 0; k < 8; ++k) { const int idx = tid + k * NTHREADS; const int cc = idx >> 3, ch = idx & 7;
            const f32x4 v = *(const f32x4*)(CONVT + ((size_t)cc * 4 + b) * SEQ + tt + ch * 4);
#pragma unroll
            for (int e = 0; e < 4; ++e) Cs[(ch * 4 + e) * PO_LD + cc] = v[e]; }
        __syncthreads();
        for (int ti = 0; ti < 4; ++ti) {
            const int tl = wid * 4 + ti, t = tt + tl;
            const bf16_t* row = PB + (size_t)(b * SEQ + t) * NPROJ;
            const bool okm = t > 0, okp = t < SEQ - 1;
            const u32x4 zero4 = (u32x4){0u, 0u, 0u, 0u};
            u32x4 hr[3][3], sr[7], ar[2];
#pragma unroll
            for (int part = 0; part < 3; ++part) { hr[part][0] = okm ? *(const u32x4*)(row - NPROJ + part * 512 + c) : zero4; hr[part][1] = *(const u32x4*)(row + part * 512 + c); hr[part][2] = okp ? *(const u32x4*)(row + NPROJ + part * 512 + c) : zero4; }
            sr[0] = *(const u32x4*)(row + 1536 + c);
            sr[1] = okm ? *(const u32x4*)(row - NPROJ + 2048 + c) : zero4; sr[2] = okm ? *(const u32x4*)(row - NPROJ + 2560 + c) : zero4;
            sr[3] = *(const u32x4*)(row + 2048 + c); sr[4] = *(const u32x4*)(row + 2560 + c);
            sr[5] = okp ? *(const u32x4*)(row + NPROJ + 2048 + c) : zero4; sr[6] = okp ? *(const u32x4*)(row + NPROJ + 2560 + c) : zero4;
            const bf16_t* ya = YAT + (size_t)(b * SEQ + t) * 1024;
            ar[0] = *(const u32x4*)(ya + c); ar[1] = *(const u32x4*)(ya + 512 + c);
            const f32x4 c0 = *(const LAS f32x4*)(Cs + tl * PO_LD + c), c1 = *(const LAS f32x4*)(Cs + tl * PO_LD + c + 4);
#define UNP(v, f) do { f[0] = bflo(v.x); f[1] = bfhi(v.x); f[2] = bflo(v.y); f[3] = bfhi(v.y); f[4] = bflo(v.z); f[5] = bfhi(v.z); f[6] = bflo(v.w); f[7] = bfhi(v.w); } while (0)
            float yh[8], ys[8], a0[8], a1[8]; float ssh = 0.f, sss = 0.f, ssa = 0.f;
            {
                float um[3][8];
#pragma unroll
                for (int part = 0; part < 3; ++part) {
                    float pm[8], pc[8], pp[8];
                    UNP(hr[part][0], pm); UNP(hr[part][1], pc); UNP(hr[part][2], pp);
#pragma unroll
                    for (int hh = 0; hh < 2; ++hh) { const f32x4 w0 = *(const f32x4*)(sw + part * 512 + c + hh * 4), w1 = *(const f32x4*)(sw + 1536 + part * 512 + c + hh * 4), w2 = *(const f32x4*)(sw + 3072 + part * 512 + c + hh * 4), bb = *(const f32x4*)(sb + part * 512 + c + hh * 4);
#pragma unroll
                        for (int e = 0; e < 4; ++e) um[part][hh * 4 + e] = w0[e] * pm[hh * 4 + e] + w1[e] * pc[hh * 4 + e] + w2[e] * pp[hh * 4 + e] + bb[e]; }
                }
                const f32x4 d0 = *(const f32x4*)(bd + c), d1 = *(const f32x4*)(bd + c + 4);
#pragma unroll
                for (int e = 0; e < 8; ++e) { const float zv = um[2][e] * um[1][e]; const float cv = e < 4 ? c0[e] : c1[e - 4]; const float dd = e < 4 ? d0[e] : d1[e - 4];
                    yh[e] = um[0][e] * (cv + zv * dd); ssh += yh[e] * yh[e]; }
            }
            {
                float gbv[8], cm[8], hm[8], cc0[8], hc[8], cp[8], hp[8];
                UNP(sr[0], gbv); UNP(sr[1], cm); UNP(sr[2], hm); UNP(sr[3], cc0); UNP(sr[4], hc); UNP(sr[5], cp); UNP(sr[6], hp);
#pragma unroll
                for (int hh = 0; hh < 2; ++hh) { const f32x4 w0 = *(const f32x4*)(cw + c + hh * 4), w1 = *(const f32x4*)(cw + 512 + c + hh * 4), w2 = *(const f32x4*)(cw + 1024 + c + hh * 4);
#pragma unroll
                    for (int e = 0; e < 4; ++e) { const int k = hh * 4 + e; const float y = gbv[k] * (w0[e] * cm[k] * hm[k] + w1[e] * cc0[k] * hc[k] + w2[e] * cp[k] * hp[k]); ys[k] = y; sss += y * y; } }
            }
            UNP(ar[0], a0); UNP(ar[1], a1);
#pragma unroll
            for (int e = 0; e < 8; ++e) ssa += a0[e] * a0[e] + a1[e] * a1[e];
#undef UNP
#pragma unroll
            for (int o = 32; o >= 1; o >>= 1) { ssh += __shfl_xor(ssh, o); sss += __shfl_xor(sss, o); ssa += __shfl_xor(ssa, o); }
            const float rh = rsqrtf(ssh * (1.0f / 512.0f) + EPS), rsc = rsqrtf(sss * (1.0f / 512.0f) + EPS), ra = rsqrtf(ssa * (1.0f / 1024.0f) + EPS);
            bf16_t* yo = YB + (size_t)(b * SEQ + t) * DM;
            *(u32x4*)(yo + c) = (u32x4){pk2(yh[0] * rh, yh[1] * rh), pk2(yh[2] * rh, yh[3] * rh), pk2(yh[4] * rh, yh[5] * rh), pk2(yh[6] * rh, yh[7] * rh)};
            *(u32x4*)(yo + 512 + c) = (u32x4){pk2(ys[0] * rsc, ys[1] * rsc), pk2(ys[2] * rsc, ys[3] * rsc), pk2(ys[4] * rsc, ys[5] * rsc), pk2(ys[6] * rsc, ys[7] * rsc)};
            *(u32x4*)(yo + 1024 + c) = (u32x4){pk2(a0[0] * ra, a0[1] * ra), pk2(a0[2] * ra, a0[3] * ra), pk2(a0[4] * ra, a0[5] * ra), pk2(a0[6] * ra, a0[7] * ra)};
            *(u32x4*)(yo + 1536 + c) = (u32x4){pk2(a1[0] * ra, a1[1] * ra), pk2(a1[2] * ra, a1[3] * ra), pk2(a1[4] * ra, a1[5] * ra), pk2(a1[6] * ra, a1[7] * ra)};
        }
    }
    __syncthreads();
}

#define XB_TMO      128
#define XB_XCNT(j)  (256  + 64 * (j))
#define XB_XSUB(j)  (1280 + 64 * (j))
#define XB_XGEN(j)  (2304 + 64 * (j))
#define XB_TOP      3328
#define XB_TOPGEN   3392
#define XCD_BAR_WORDS 3456
#define XB_SPIN_CAP (1u << 18)

__device__ __forceinline__ unsigned xb_ld(unsigned* p)              { return __hip_atomic_load(p, __ATOMIC_RELAXED, __HIP_MEMORY_SCOPE_AGENT); }
__device__ __forceinline__ unsigned xb_add(unsigned* p, unsigned v) { return __hip_atomic_fetch_add(p, v, __ATOMIC_RELAXED, __HIP_MEMORY_SCOPE_AGENT); }
__device__ __forceinline__ unsigned xb_xcc_id() { return (unsigned)__builtin_amdgcn_s_getreg((3 << 11) | 20) & 0xFu; }
#define XB_SPIN(cond, bar) do { unsigned _sp = 0; while (cond) { __builtin_amdgcn_s_sleep(1); \
    if ((++_sp & 255u) == 0u) { if (xb_ld(&(bar)[XB_TMO])) break; if (_sp > XB_SPIN_CAP) { atomicAdd(&(bar)[XB_TMO], 1u); break; } } } } while (0)

struct XcdBarrier {
    unsigned* bar; unsigned x;
    volatile LAS unsigned* st;
};

__device__ __forceinline__ XcdBarrier xcd_barrier_post(unsigned* bar, volatile LAS unsigned* st) {
    XcdBarrier b; b.bar = bar; b.x = xb_xcc_id(); b.st = st;
    if (threadIdx.x == 0) (void)xb_add(&bar[XB_XCNT(b.x)], 1u);
    return b;
}
__device__ __forceinline__ void xcd_barrier_complete(unsigned* bar, unsigned x, unsigned& nloc, unsigned& nx) {
    const unsigned G = gridDim.x * gridDim.y * gridDim.z;
    unsigned sum, cnt, mine, sp = 0u;
    for (;;) {
        sum = 0u; cnt = 0u; mine = 0u;
#pragma unroll
        for (unsigned j = 0; j < 16; ++j) { const unsigned c = xb_ld(&bar[XB_XCNT(j)]); sum += c; cnt += (c > 0u) ? 1u : 0u; mine = (j == x) ? c : mine; }
        if (sum == G) break;
        __builtin_amdgcn_s_sleep(1);
        if ((++sp & 255u) == 0u) { if (xb_ld(&bar[XB_TMO])) break; if (sp > XB_SPIN_CAP) { atomicAdd(&bar[XB_TMO], 1u); break; } }
    }
    nloc = mine > 0u ? mine : 1u; nx = cnt > 0u ? cnt : 1u;
}

__device__ __forceinline__ void xcd_barrier(const XcdBarrier& b) {
    asm volatile("s_waitcnt vmcnt(0)" ::: "memory");
    __syncthreads();
    if (threadIdx.x == 0) {
        unsigned* bar = b.bar;
        __builtin_amdgcn_s_waitcnt(0);
        unsigned nloc = b.st[0], nx = b.st[1];
        if (nloc == 0u) { xcd_barrier_complete(bar, b.x, nloc, nx); b.st[0] = nloc; b.st[1] = nx; }
        const unsigned old = xb_add(&bar[XB_XSUB(b.x)], 1u);
        const unsigned gen = old / nloc;
        if (old + 1u == (gen + 1u) * nloc) {
            __builtin_amdgcn_fence(__ATOMIC_RELEASE, "agent");
            asm volatile("s_waitcnt vmcnt(0)" ::: "memory");
            const unsigned og = xb_add(&bar[XB_TOP], 1u);
            const unsigned tg = og / nx;
            if (og + 1u == (tg + 1u) * nx) xb_add(&bar[XB_TOPGEN], 1u);
            else XB_SPIN(xb_ld(&bar[XB_TOPGEN]) == tg, bar);
            __builtin_amdgcn_fence(__ATOMIC_ACQUIRE, "agent");
            xb_add(&bar[XB_XGEN(b.x)], 1u);
            asm volatile("s_waitcnt vmcnt(0)" ::: "memory");
        } else {
            XB_SPIN(xb_ld(&bar[XB_XGEN(b.x)]) == gen, bar);
            __builtin_amdgcn_fence(__ATOMIC_ACQUIRE, "agent");
            asm volatile("s_waitcnt vmcnt(0)" ::: "memory");
        }
    }
    __syncthreads();
}


template <class Epi> __device__ __forceinline__ void run_gemm(LAS unsigned char* lds, const bf16_t* A, const bf16_t* Bt, int N, int K, const Epi& E) {
    pg8::Gemm g{A, Bt, MTOK, N, K}; pg8::StaticOrder S; S.init(MTOK, N, (int)gridDim.x, (int)blockIdx.x);
    pg8::gemm_phase<Epi, pg8::StaticOrder, false>(lds, g, S, E, nullptr);
}

constexpr int N_PHASES = 19;
#define IN(k) (lo <= (k) && (k) < hi)
#define SEAM(k) do { if (IN(k) && IN((k) + 1)) { if (lo < 0) grid.sync(); else xcd_barrier(bar); } } while (0)
template <int L> __device__ __forceinline__ void layer_fwd(const Params& p, LAS unsigned char* lds, cg::grid_group& grid, const XcdBarrier& bar, const int lo, const int hi) {
    unsigned char* ws = p.ws;
    bf16_t* XB = (bf16_t*)(ws + WS_HB); bf16_t* ACT = (bf16_t*)(ws + WS_ACT); bf16_t* PB = (bf16_t*)(ws + WS_PB); bf16_t* YB = (bf16_t*)(ws + WS_YB);
    unsigned long long* SS = (unsigned long long*)(ws + WS_SS) + (size_t)(3 * L) * MTOK;
    constexpr int P0 = 1 + 9 * L;
    if (IN(P0 + 0)) { pg8::EpiGU E{ACT, DFF, SS}; run_gemm(lds, XB, (const bf16_t*)(ws + WS_WGU + (size_t)(L * 2 + 0) * SZ_WGU), 2 * DFF, DM, E); } SEAM(P0 + 0);
    if (IN(P0 + 1)) { pg8::EpiResB E{XB, nullptr, DM, 0.5f, SS + MTOK}; run_gemm(lds, ACT, (const bf16_t*)(ws + WS_WDN + (size_t)(L * 2 + 0) * SZ_WDN), DM, DFF, E); } SEAM(P0 + 1);
    if (IN(P0 + 2)) { pg8::EpiB16 E{PB, NPROJ, SS + MTOK}; run_gemm(lds, XB, (const bf16_t*)(ws + WS_WIN + (size_t)L * SZ_WIN), NPROJ, DM, E); } SEAM(P0 + 2);
    if (IN(P0 + 3)) { phase_hyprep(p, L); } SEAM(P0 + 3);
    if (IN(P0 + 4)) { phase_mix(p, L, lds); } SEAM(P0 + 4);
    if (IN(P0 + 5)) { phase_post(p, L, lds); } SEAM(P0 + 5);
    if (IN(P0 + 6)) { pg8::EpiResB E{XB, nullptr, DM, 1.0f, SS + 2 * MTOK}; run_gemm(lds, YB, (const bf16_t*)(ws + WS_WOUT + (size_t)L * SZ_WOUT), DM, DM, E); } SEAM(P0 + 6);
    if (IN(P0 + 7)) { pg8::EpiGU E{ACT, DFF, SS + 2 * MTOK}; run_gemm(lds, XB, (const bf16_t*)(ws + WS_WGU + (size_t)(L * 2 + 1) * SZ_WGU), 2 * DFF, DM, E); } SEAM(P0 + 7);
    if (IN(P0 + 8)) { pg8::EpiResB E{XB, L == 1 ? p.out : nullptr, DM, 0.5f, L == 1 ? nullptr : SS + 3 * MTOK}; run_gemm(lds, ACT, (const bf16_t*)(ws + WS_WDN + (size_t)(L * 2 + 1) * SZ_WDN), DM, DFF, E); }
    if (L == 0) SEAM(P0 + 8);
}
__global__ void __launch_bounds__(NTHREADS, 2) mega_fwd(Params p) {
    extern __shared__ __attribute__((aligned(16))) unsigned char shm[];
    LAS unsigned char* lds = (LAS unsigned char*)shm;
    cg::grid_group grid = cg::this_grid();
    const int lo = p.ph_lo, hi = p.ph_hi;
    if (threadIdx.x < 4) ((LAS unsigned*)(lds + BAR_LDS_OFF))[threadIdx.x] = 0u;
    __syncthreads();
    const XcdBarrier bar = xcd_barrier_post((unsigned*)(p.ws + WS_BAR), (volatile LAS unsigned*)(lds + BAR_LDS_OFF));
    if (IN(0)) { phase_x0(p.in[0], (bf16_t*)(p.ws + WS_HB), (unsigned long long*)(p.ws + WS_SS)); phase_filter(p, lds); phase_convert(p, lds); } SEAM(0);
    layer_fwd<0>(p, lds, grid, bar, lo, hi);
    layer_fwd<1>(p, lds, grid, bar, lo, hi);
}

extern "C" void kernel_launch(void* const* d_in, const int* in_sizes, int n_in, void* d_out, int out_size, void* d_ws, size_t ws_size, hipStream_t stream) {
    static int grid = 0;
    if (grid == 0) {
        if (n_in != 28 || in_sizes[0] != MTOK * DM || out_size != MTOK * DM || ws_size < WS_END) { fprintf(stderr, "kernel_launch: unexpected shapes / workspace (n_in %d, ws %zu < %zu)\n", n_in, ws_size, (size_t)WS_END); grid = -1; return; }
        int dev = 0, cus = 0, per_cu = 0;
        hipGetDevice(&dev); hipDeviceGetAttribute(&cus, hipDeviceAttributeMultiprocessorCount, dev);
        if (hipFuncSetAttribute((const void*)mega_fwd, hipFuncAttributeMaxDynamicSharedMemorySize, LDS_BYTES) != hipSuccess) { fprintf(stderr, "kernel_launch: hipFuncSetAttribute failed\n"); grid = -1; return; }
        if (hipOccupancyMaxActiveBlocksPerMultiprocessor(&per_cu, (const void*)mega_fwd, NTHREADS, LDS_BYTES) != hipSuccess || per_cu < 1) { fprintf(stderr, "kernel_launch: occupancy query gave %d\n", per_cu); per_cu = 1; }
        (void)hipGetLastError();
        grid = cus * per_cu;
    }
    if (grid < 0) return;
    Params p{};
    for (int i = 0; i < 28; ++i) p.in[i] = (const float*)d_in[i];
    p.out = (float*)d_out; p.ws = (unsigned char*)d_ws;
    (void)hipMemsetAsync((unsigned char*)d_ws + WS_BAR, 0, 16384, stream);
#if defined(MK_PER_PHASE)
    for (int ph = 0; ph < N_PHASES; ++ph) { p.ph_lo = ph; p.ph_hi = ph + 1; hipLaunchKernelGGL(mega_fwd, dim3(grid), dim3(NTHREADS), LDS_BYTES, stream, p); }
#else
    p.ph_lo = 0; p.ph_hi = N_PHASES;
    void* args[] = {&p};
    hipError_t e = hipLaunchCooperativeKernel((const void*)mega_fwd, dim3(grid), dim3(NTHREADS), args, LDS_BYTES, stream);
    if (e != hipSuccess) fprintf(stderr, "cooperative launch failed: %s (grid %d)\n", hipGetErrorString(e), grid);
#endif
}
```
